# Optimizing an MI355X kernel written in HIP

```python
import math
import jax, jax.numpy as jnp
from jax import lax
import numpy as np

D_MODEL = 2048
BATCH = 4
SEQ = 2048
DEPTH = 4

GRID_W = 64
CTX_LEN = 256
N_GROUPS = 4
HEADS_PER_GROUP = 4
HEAD_W = D_MODEL // (N_GROUPS * HEADS_PER_GROUP)
GROUP_W = HEADS_PER_GROUP * HEAD_W
D_MIX = N_GROUPS * GROUP_W
A_DK = HEAD_W
A_DV = HEAD_W
B_DH = HEAD_W // 2
C_DH = HEAD_W
NA_KH = 8
NA_KW = 16
D_DK = HEAD_W
D_DV = HEAD_W
D_FF = 5632
CONV_W = 3
CHUNK = 64
Q_BLOCK = 128
ROPE_THETA = 10000.0
EPS = 1e-6
SPLIT_A = (GROUP_W,) * 5
SPLIT_B = (GROUP_W,) * 3
SPLIT_C = (GROUP_W,) * 3
SPLIT_D = (GROUP_W,) * 4 + (4 * HEADS_PER_GROUP,)
GROUP_SPLIT = (sum(SPLIT_A), sum(SPLIT_B), sum(SPLIT_C), sum(SPLIT_D))
D_IN = sum(GROUP_SPLIT)

kernel_name = 'hybrid_flow_backbone'

F32 = jnp.float32


def _split(t, sizes):
    return jnp.split(t, [int(s) for s in np.cumsum(sizes)[:-1]], axis=-1)


def rmsnorm(t, w=None):
    tf = t.astype(F32)
    y = tf * lax.rsqrt(jnp.mean(tf * tf, axis=-1, keepdims=True) + EPS)
    if w is not None:
        y = y * w.astype(F32)
    return y.astype(t.dtype)


def modulate(t, shift, scale):
    return rmsnorm(t) * (1 + scale) + shift


def heads(t):
    b, n, _ = t.shape
    return t.reshape(b, n, HEADS_PER_GROUP, -1).transpose(0, 2, 1, 3)


def merge(t):
    b, h, n, d = t.shape
    return t.transpose(0, 2, 1, 3).reshape(b, n, h * d)


def head_norm(o, w):
    h, d = o.shape[1], o.shape[3]
    return merge(rmsnorm(o.astype(F32)) * w.astype(F32).reshape(h, 1, d))


def flip_seq(t):
    return jnp.flip(t, axis=2)


def to_chunks(t):
    b, h, n = t.shape[:3]
    return jnp.moveaxis(t.reshape(b, h, n // CHUNK, CHUNK, *t.shape[3:]), 2, 0)


def from_chunks(t):
    nc, b, h, L = t.shape[:4]
    return jnp.moveaxis(t, 0, 2).reshape(b, h, nc * L, *t.shape[4:])


def lambda_init(layer_idx):
    return 0.8 - 0.6 * math.exp(-0.3 * layer_idx)


def axial_rope(n):
    t = jnp.arange(n)
    row = (t // GRID_W).astype(F32)
    col = (t % GRID_W).astype(F32)
    half = B_DH // 2
    inv = ROPE_THETA ** (-jnp.arange(0, half, 2, dtype=F32) / half)
    ar = row[:, None] * inv
    ac = col[:, None] * inv
    ang = jnp.concatenate([ar, ar, ac, ac], axis=-1)
    return jnp.cos(ang), jnp.sin(ang)


def apply_rope(t, cos, sin):
    r1, r2, c1, c2 = jnp.split(t, 4, axis=-1)
    rot = jnp.concatenate([-r2, r1, -c2, c1], axis=-1)
    return t * cos.astype(t.dtype) + rot * sin.astype(t.dtype)


def gla_scan(q, k, v, log_f, s0, with_out):
    tri = jnp.tril(jnp.ones((CHUNK, CHUNK), bool))

    def body(S, inp):
        qc, kc, vc, gc = inp
        b = jnp.cumsum(gc, axis=2)
        b_last = b[:, :, -1:]
        S_new = jnp.exp(b_last)[:, :, 0, :, None] * S + jnp.einsum('bhsd,bhse->bhde', kc * jnp.exp(b_last - b), vc)
        if not with_out:
            return S_new, None
        rel = jnp.where(tri[:, :, None], b[:, :, :, None, :] - b[:, :, None, :, :], -jnp.inf)
        A = jnp.einsum('bhtd,bhsd,bhtsd->bhts', qc, kc, jnp.exp(rel))
        o = jnp.einsum('bhtd,bhde->bhte', qc * jnp.exp(b), S) + jnp.einsum('bhts,bhse->bhte', A, vc)
        return S_new, o

    S, o = lax.scan(body, s0, tuple(to_chunks(t) for t in (q, k, v, log_f)))
    return (from_chunks(o) if with_out else None), S


def mlstm_scan(q, k, v, log_i, log_f, state, with_out):
    tri = jnp.tril(jnp.ones((CHUNK, CHUNK), bool))

    def body(carry, inp):
        C, n, m = carry
        qc, kc, vc, ic, fc = inp
        b = jnp.cumsum(fc, axis=-1)
        b_last = b[..., -1]
        upd = b_last[..., None] - b + ic
        m_new = jnp.maximum(b_last + m, jnp.max(upd, axis=-1))
        w_s = jnp.exp(b_last + m - m_new)
        w_u = jnp.exp(upd - m_new[..., None])
        C_new = w_s[..., None, None] * C + jnp.einsum('bhs,bhsd,bhse->bhde', w_u, kc, vc)
        n_new = w_s[..., None] * n + jnp.einsum('bhs,bhsd->bhd', w_u, kc)
        if not with_out:
            return (C_new, n_new, m_new), None
        log_w = jnp.where(tri, b[..., :, None] - b[..., None, :] + ic[..., None, :], -jnp.inf)
        inter = b + m[..., None]
        m_t = jnp.maximum(inter, jnp.max(log_w, axis=-1))
        w_inter = jnp.exp(inter - m_t)
        w_intra = jnp.exp(log_w - m_t[..., None]) * jnp.einsum('bhtd,bhsd->bhts', qc, kc)
        num = w_inter[..., None] * jnp.einsum('bhtd,bhde->bhte', qc, C) + jnp.einsum('bhts,bhse->bhte', w_intra, vc)
        den = w_inter * jnp.einsum('bhtd,bhd->bht', qc, n) + jnp.sum(w_intra, axis=-1)
        h = num / jnp.maximum(jnp.abs(den), jnp.exp(-m_t))[..., None]
        return (C_new, n_new, m_new), h

    state, h = lax.scan(body, state, tuple(to_chunks(t) for t in (q, k, v, log_i, log_f)))
    return (from_chunks(h) if with_out else None), state


def hgrn2_mixer(p_x, p_c, lb, norm_w, ctx_out):
    log_lb, log_ub = jnp.log(lb), jnp.log1p(-lb)

    def prep(p):
        q, i, zf, zb, g = _split(p.astype(F32), SPLIT_A)
        q = heads(jax.nn.silu(q)) * A_DK ** -0.5
        lf = [heads(jnp.logaddexp(log_lb[d], log_ub[d] + jax.nn.log_sigmoid(z))) for d, z in enumerate((zf, zb))]
        kk = [-jnp.expm1(t) for t in lf]
        return q, heads(i), kk, lf, g

    qx, vx, kx, lfx, gx = prep(p_x)
    qc, vc, kc, lfc, gc = prep(p_c)
    s0 = jnp.zeros((qc.shape[0], HEADS_PER_GROUP, A_DK, A_DV), F32)
    oc_f, sc_f = gla_scan(qc, kc[0], vc, lfc[0], s0, ctx_out)
    oc_b, sc_b = gla_scan(flip_seq(qc), flip_seq(kc[1]), flip_seq(vc), flip_seq(lfc[1]), s0, ctx_out)
    ox_f, _ = gla_scan(qx, kx[0], vx, lfx[0], sc_f, True)
    ox_b, _ = gla_scan(flip_seq(qx), flip_seq(kx[1]), flip_seq(vx), flip_seq(lfx[1]), sc_b, True)
    y_x = (head_norm(ox_f + flip_seq(ox_b), norm_w) * jax.nn.silu(gx)).astype(p_x.dtype)
    y_c = (head_norm(oc_f + flip_seq(oc_b), norm_w) * jax.nn.silu(gc)).astype(p_c.dtype) if ctx_out else None
    return y_x, y_c


def diff_attention(p_x, p_c, lam, norm_w, lam_init, cos, sin, ctx_out):
    def prep(p, rope):
        q, k, v = _split(p, SPLIT_B)
        b, n, _ = q.shape
        q = q.reshape(b, n, HEADS_PER_GROUP, 2, B_DH).transpose(0, 2, 3, 1, 4)
        k = k.reshape(b, n, HEADS_PER_GROUP, 2, B_DH).transpose(0, 2, 3, 1, 4)
        if rope:
            q, k = apply_rope(q, cos, sin), apply_rope(k, cos, sin)
        return q, k, heads(v)

    qx, kx, vx = prep(p_x, True)
    qc, kc, vc = prep(p_c, False)
    lf = lam.astype(F32)
    lam_full = jnp.exp(jnp.sum(lf[0] * lf[1])) - jnp.exp(jnp.sum(lf[2] * lf[3])) + lam_init
    scale = B_DH ** -0.5

    def attend(q, k, v):
        s = jnp.einsum('bhcqd,bhckd->bhcqk', q, k).astype(F32) * scale
        p = jax.nn.softmax(s, axis=-1)
        w = p[:, :, 0] - lam_full * p[:, :, 1]
        return jnp.einsum('bhqk,bhke->bhqe', w.astype(v.dtype), v)

    k_all = jnp.concatenate([kx, kc], axis=3)
    v_all = jnp.concatenate([vx, vc], axis=2)
    b, h, _, n, dh = qx.shape
    nb = n // Q_BLOCK
    qb = qx.reshape(b, h, 2, nb, Q_BLOCK, dh).transpose(3, 0, 1, 2, 4, 5)
    ob = lax.map(lambda qq: attend(qq, k_all, v_all), qb)
    o_x = ob.transpose(1, 2, 0, 3, 4).reshape(b, h, n, 2 * B_DH)
    y_x = (head_norm(o_x, norm_w) * (1 - lam_init)).astype(p_x.dtype)
    y_c = (head_norm(attend(qc, kc, vc), norm_w) * (1 - lam_init)).astype(p_c.dtype) if ctx_out else None
    return y_x, y_c


def neighbourhood_attention(p_x, p_c, rpb, rows, ctx_out):
    qx, kx, vx = [heads(t) for t in _split(p_x, SPLIT_C)]
    qc, kc, vc = [heads(t) for t in _split(p_c, SPLIT_C)]
    b, h, n, dh = qx.shape
    kh = min(NA_KH, rows)
    scale = C_DH ** -0.5
    qg = qx.reshape(b, h, rows, GRID_W, dh) * scale
    kg = kx.reshape(b, h, rows, GRID_W, dh)
    vg = vx.reshape(b, h, rows, GRID_W, dh)
    r = jnp.arange(rows)
    w = jnp.arange(GRID_W)
    row_idx = jnp.clip(r - kh // 2, 0, rows - kh)[:, None] + jnp.arange(kh)[None, :]
    col_start = jnp.clip(w - NA_KW // 2, 0, GRID_W - NA_KW)
    col_ok = (w[None, :] >= col_start[:, None]) & (w[None, :] < col_start[:, None] + NA_KW)
    k_band = kg[:, :, row_idx]
    v_band = vg[:, :, row_idx]
    s_band = jnp.einsum('bhrqd,bhrkwd->bhrqkw', qg, k_band).astype(F32)
    roff = row_idx - r[:, None] + (NA_KH - 1)
    coff = jnp.clip(w[None, :] - w[:, None], -(NA_KW - 1), NA_KW - 1) + (NA_KW - 1)
    bias = rpb.astype(F32)[:, roff[:, None, :, None], coff[None, :, None, :]]
    s_band = jnp.where(col_ok[:, None, :], s_band + bias, -jnp.inf)
    s_ctx = jnp.einsum('bhrqd,bhcd->bhrqc', qg, kc).astype(F32)
    s = jnp.concatenate([s_band.reshape(b, h, rows, GRID_W, kh * GRID_W), s_ctx], axis=-1)
    p = jax.nn.softmax(s, axis=-1).astype(vx.dtype)
    p_band = p[..., :kh * GRID_W].reshape(b, h, rows, GRID_W, kh, GRID_W)
    p_ctx = p[..., kh * GRID_W:]
    o = jnp.einsum('bhrqkw,bhrkwd->bhrqd', p_band, v_band) + jnp.einsum('bhrqc,bhcd->bhrqd', p_ctx, vc)
    y_x = merge(o.reshape(b, h, n, dh))
    y_c = None
    if ctx_out:
        pc = jax.nn.softmax(jnp.einsum('bhqd,bhkd->bhqk', qc, kc).astype(F32) * scale, axis=-1).astype(vc.dtype)
        y_c = merge(jnp.einsum('bhqk,bhkd->bhqd', pc, vc))
    return y_x, y_c


def mlstm_mixer(p_x, p_c, f_bias, norm_w, ctx_out):
    fb = f_bias.astype(F32)[:, :, None]

    def prep(p):
        q, k, v, o, gates = _split(p.astype(F32), SPLIT_D)
        b, n, _ = gates.shape
        gates = gates.reshape(b, n, 4, HEADS_PER_GROUP).transpose(2, 0, 3, 1)
        log_i = (gates[0], gates[2])
        log_f = (jax.nn.log_sigmoid(gates[1] + fb[0]), jax.nn.log_sigmoid(gates[3] + fb[1]))
        return heads(q) * D_DK ** -0.5, heads(k), heads(v), heads(jax.nn.sigmoid(o)), log_i, log_f

    qx, kx, vx, ox, ix, fx = prep(p_x)
    qc, kc, vc, oc, ic, fc = prep(p_c)
    b = qc.shape[0]
    st0 = (jnp.zeros((b, HEADS_PER_GROUP, D_DK, D_DV), F32), jnp.zeros((b, HEADS_PER_GROUP, D_DK), F32),
           jnp.zeros((b, HEADS_PER_GROUP), F32))
    hc_f, st_f = mlstm_scan(qc, kc, vc, ic[0], fc[0], st0, ctx_out)
    hc_b, st_b = mlstm_scan(flip_seq(qc), flip_seq(kc), flip_seq(vc), flip_seq(ic[1]), flip_seq(fc[1]), st0, ctx_out)
    hx_f, _ = mlstm_scan(qx, kx, vx, ix[0], fx[0], st_f, True)
    hx_b, _ = mlstm_scan(flip_seq(qx), flip_seq(kx), flip_seq(vx), flip_seq(ix[1]), flip_seq(fx[1]), st_b, True)
    y_x = head_norm(ox * (hx_f + flip_seq(hx_b)), norm_w).astype(p_x.dtype)
    y_c = head_norm(oc * (hc_f + flip_seq(hc_b)), norm_w).astype(p_c.dtype) if ctx_out else None
    return y_x, y_c


def conv_ffn(h, w_up, conv_w, conv_b, w_down):
    u = h @ w_up
    n = u.shape[1]
    pad = CONV_W // 2
    up = jnp.pad(u, ((0, 0), (pad, pad), (0, 0)))
    u = sum(up[:, j:j + n] * conv_w[j] for j in range(CONV_W)) + conv_b
    a, g = jnp.split(u, 2, axis=-1)
    return (jax.nn.silu(a) * g) @ w_down


def setup_inputs(seed: int = 0) -> dict:
    key = jax.random.key(seed)
    ks = jax.random.split(key, 20)

    def nrm(k, shape, s):
        return jax.random.normal(k, shape, F32) * s

    return {
        'x': nrm(ks[0], (BATCH, SEQ, D_MODEL), 1.0),
        'c': nrm(ks[1], (BATCH, D_MODEL), 1.0),
        'ctx': nrm(ks[2], (BATCH, CTX_LEN, D_MODEL), 1.0),
        'c_ctx': nrm(ks[3], (D_MODEL,), 1.0),
        'w_ada': nrm(ks[4], (DEPTH, D_MODEL, 6 * D_MODEL), 0.5 * D_MODEL ** -0.5),
        'b_ada': nrm(ks[5], (DEPTH, 6 * D_MODEL), 0.02),
        'w_in': nrm(ks[6], (DEPTH, D_MODEL, D_IN), D_MODEL ** -0.5),
        'hgrn_lb': nrm(ks[7], (DEPTH, 2, GROUP_W), 0.1),
        'hgrn_norm_w': 1.0 + nrm(ks[8], (DEPTH, GROUP_W), 0.1),
        'diff_lam': nrm(ks[9], (DEPTH, 4, B_DH), 0.1),
        'diff_norm_w': 1.0 + nrm(ks[10], (DEPTH, GROUP_W), 0.1),
        'na_rpb': nrm(ks[11], (DEPTH, HEADS_PER_GROUP, 2 * NA_KH - 1, 2 * NA_KW - 1), 0.02),
        'mlstm_f_bias': 3.0 + nrm(ks[12], (DEPTH, 2, HEADS_PER_GROUP), 0.5),
        'mlstm_norm_w': 1.0 + nrm(ks[13], (DEPTH, GROUP_W), 0.1),
        'w_out': nrm(ks[14], (DEPTH, D_MIX, D_MODEL), D_MIX ** -0.5),
        'w_up': nrm(ks[15], (DEPTH, D_MODEL, 2 * D_FF), D_MODEL ** -0.5),
        'conv_w': nrm(ks[16], (DEPTH, CONV_W, 2 * D_FF), CONV_W ** -0.5),
        'conv_b': nrm(ks[17], (DEPTH, 2 * D_FF), 0.02),
        'w_down': nrm(ks[18], (DEPTH, D_FF, D_MODEL), D_FF ** -0.5),
        'final_norm_w': 1.0 + nrm(ks[19], (D_MODEL,), 0.1),
    }


def reference(x, c, ctx, c_ctx, w_ada, b_ada, w_in, hgrn_lb, hgrn_norm_w, diff_lam, diff_norm_w, na_rpb,
              mlstm_f_bias, mlstm_norm_w, w_out, w_up, conv_w, conv_b, w_down, final_norm_w):
    n = x.shape[1]
    rows = n // GRID_W
    cos, sin = axial_rope(n)
    lb = jnp.cumsum(jax.nn.softmax(hgrn_lb.astype(F32), axis=0), axis=0)
    lb = lb - lb[:1]
    cx = ctx
    for l in range(DEPTH):
        ctx_out = l < DEPTH - 1
        mod_x = (jax.nn.silu(c) @ w_ada[l] + b_ada[l])[:, None, :]
        mod_c = jax.nn.silu(c_ctx) @ w_ada[l] + b_ada[l]
        sh1, sc1, g1, sh2, sc2, g2 = jnp.split(mod_x, 6, axis=-1)
        csh1, csc1, cg1, csh2, csc2, cg2 = jnp.split(mod_c, 6, axis=-1)
        pxa, pxb, pxc, pxd = _split(modulate(x, sh1, sc1) @ w_in[l], GROUP_SPLIT)
        pca, pcb, pcc, pcd = _split(modulate(cx, csh1, csc1) @ w_in[l], GROUP_SPLIT)
        ya_x, ya_c = hgrn2_mixer(pxa, pca, lb[l], hgrn_norm_w[l], ctx_out)
        yb_x, yb_c = diff_attention(pxb, pcb, diff_lam[l], diff_norm_w[l], lambda_init(l), cos, sin, ctx_out)
        yc_x, yc_c = neighbourhood_attention(pxc, pcc, na_rpb[l], rows, ctx_out)
        yd_x, yd_c = mlstm_mixer(pxd, pcd, mlstm_f_bias[l], mlstm_norm_w[l], ctx_out)
        x = x + g1 * (jnp.concatenate([ya_x, yb_x, yc_x, yd_x], axis=-1) @ w_out[l])
        x = x + g2 * conv_ffn(modulate(x, sh2, sc2), w_up[l], conv_w[l], conv_b[l], w_down[l])
        if ctx_out:
            cx = cx + cg1 * (jnp.concatenate([ya_c, yb_c, yc_c, yd_c], axis=-1) @ w_out[l])
            cx = cx + cg2 * conv_ffn(modulate(cx, csh2, csc2), w_up[l], conv_w[l], conv_b[l], w_down[l])
    return rmsnorm(x, final_norm_w)
```

```cpp
#include <hip/hip_runtime.h>
#include <cstdio>
#include <cstdint>
#include <cstddef>
#define DEV __device__ __forceinline__
#define HD __host__ __device__
#define MDEV __device__ __forceinline__
#ifndef ONE_LAUNCH
#define ONE_LAUNCH 1
#endif
#define XB_TMO      128
#define XB_XCNT(j)  (256  + 64 * (j))
#define XB_XSUB(j)  (1280 + 64 * (j))
#define XB_XGEN(j)  (2304 + 64 * (j))
#define XB_TOP      3328
#define XB_TOPGEN   3392
#define XCD_BAR_WORDS 3456
#define XB_SPIN_CAP (1u << 18)
#define LAS __attribute__((address_space(3)))

__device__ __forceinline__ unsigned xb_ld(unsigned* p)              { return __hip_atomic_load(p, __ATOMIC_RELAXED, __HIP_MEMORY_SCOPE_AGENT); }
__device__ __forceinline__ unsigned xb_add(unsigned* p, unsigned v) { return __hip_atomic_fetch_add(p, v, __ATOMIC_RELAXED, __HIP_MEMORY_SCOPE_AGENT); }
__device__ __forceinline__ unsigned xb_xcc_id() { return (unsigned)__builtin_amdgcn_s_getreg((3 << 11) | 20) & 0xFu; }
#define XB_SPIN(cond, bar) do { unsigned _sp = 0; while (cond) { __builtin_amdgcn_s_sleep(1); \
    if ((++_sp & 255u) == 0u) { if (xb_ld(&(bar)[XB_TMO])) break; if (_sp > XB_SPIN_CAP) { atomicAdd(&(bar)[XB_TMO], 1u); break; } } } } while (0)

struct XcdBarrier {
    unsigned* bar; unsigned x;
    volatile LAS unsigned* st;
};

__device__ __forceinline__ XcdBarrier xcd_barrier_post(unsigned* bar, volatile LAS unsigned* st) {
    XcdBarrier b; b.bar = bar; b.x = xb_xcc_id(); b.st = st;
    if (threadIdx.x == 0) (void)xb_add(&bar[XB_XCNT(b.x)], 1u);
    return b;
}
__device__ __forceinline__ void xcd_barrier_complete(unsigned* bar, unsigned x, unsigned& nloc, unsigned& nx) {
    const unsigned G = gridDim.x * gridDim.y * gridDim.z;
    unsigned sum, cnt, mine, sp = 0u;
    for (;;) {
        sum = 0u; cnt = 0u; mine = 0u;
#pragma unroll
        for (unsigned j = 0; j < 16; ++j) { const unsigned c = xb_ld(&bar[XB_XCNT(j)]); sum += c; cnt += (c > 0u) ? 1u : 0u; mine = (j == x) ? c : mine; }
        if (sum == G) break;
        __builtin_amdgcn_s_sleep(1);
        if ((++sp & 255u) == 0u) { if (xb_ld(&bar[XB_TMO])) break; if (sp > XB_SPIN_CAP) { atomicAdd(&bar[XB_TMO], 1u); break; } }
    }
    nloc = mine > 0u ? mine : 1u; nx = cnt > 0u ? cnt : 1u;
}

__device__ __forceinline__ void xcd_barrier(const XcdBarrier& b) {
    asm volatile("s_waitcnt vmcnt(0)" ::: "memory");
    __syncthreads();
    if (threadIdx.x == 0) {
        unsigned* bar = b.bar;
        __builtin_amdgcn_s_waitcnt(0);
        unsigned nloc = b.st[0], nx = b.st[1];
        if (nloc == 0u) { xcd_barrier_complete(bar, b.x, nloc, nx); b.st[0] = nloc; b.st[1] = nx; }
        const unsigned old = xb_add(&bar[XB_XSUB(b.x)], 1u);
        const unsigned gen = old / nloc;
        if (old + 1u == (gen + 1u) * nloc) {
            __builtin_amdgcn_fence(__ATOMIC_RELEASE, "agent");
            asm volatile("s_waitcnt vmcnt(0)" ::: "memory");
            const unsigned og = xb_add(&bar[XB_TOP], 1u);
            const unsigned tg = og / nx;
            if (og + 1u == (tg + 1u) * nx) xb_add(&bar[XB_TOPGEN], 1u);
            else XB_SPIN(xb_ld(&bar[XB_TOPGEN]) == tg, bar);
            __builtin_amdgcn_fence(__ATOMIC_ACQUIRE, "agent");
            xb_add(&bar[XB_XGEN(b.x)], 1u);
            asm volatile("s_waitcnt vmcnt(0)" ::: "memory");
        } else {
            XB_SPIN(xb_ld(&bar[XB_XGEN(b.x)]) == gen, bar);
            __builtin_amdgcn_fence(__ATOMIC_ACQUIRE, "agent");
            asm volatile("s_waitcnt vmcnt(0)" ::: "memory");
        }
    }
    __syncthreads();
}
namespace pg8 {
#define PG8_LAS __attribute__((address_space(3)))
typedef unsigned short bf16_t;
typedef short bf16x8 __attribute__((ext_vector_type(8)));
typedef float f32x4 __attribute__((ext_vector_type(4)));
typedef unsigned u32x4 __attribute__((ext_vector_type(4)));
constexpr int BM = 256, BK = 64, HALF = 128, HTB = HALF * BK * 2  , STAGE_BYTES = 8 * HTB, NXCD = 8, WGM = 8;

__host__ __device__ __forceinline__ int lds_byte(int r, int c) { const int st = (r >> 4) * 2 + (c >> 5), rr = r & 15, cc = c & 31, ob = rr * 64 + cc * 2; return st * 1024 + (ob ^ (((ob >> 9) & 1) << 5)); }
__host__ __device__ __forceinline__ void stage_rc(int b, int& R, int& C) { const int st = b / 1024, sb = b % 1024, swz = sb ^ (((sb >> 9) & 1) << 5); R = (st >> 1) * 16 + swz / 64; C = (st & 1) * 32 + (swz % 64) / 2; }
__host__ __device__ __forceinline__ int perm32(int rho) { const int n = rho >> 4, i = rho & 15; return 8 * (i >> 2) + 4 * n + (i & 3); }

struct Unit { int pm, pn; };
struct Gemm { const bf16_t* A; const bf16_t* Bt; int M, N, K; };

struct StaticOrder {
    int nM, nN, nwg, G, c;
    __host__ __device__ void init(int M, int N, int G_, int c_) { nM = M / BM; nN = N / BM; nwg = nM * nN; G = G_; c = c_; }
    __host__ __device__ bool next(int i, Unit& u) const {
        const long L = (long)i * G + c; if (L >= nwg) return false;
        int wgid = (int)L; { const int q = nwg / NXCD, r = nwg % NXCD, xcd = wgid % NXCD, off = wgid / NXCD; wgid = (xcd < r ? xcd * (q + 1) : r * (q + 1) + (xcd - r) * q) + off; }
        const int nig = WGM * nN, gid = wgid / nig, fm = gid * WGM, gsz = (nM - fm) < WGM ? (nM - fm) : WGM;
        u.pm = fm + ((wgid % nig) % gsz); u.pn = (wgid % nig) / gsz; return true;
    }
    __device__ __forceinline__ void a_ready(const Unit&) const {}
    __device__ __forceinline__ void done(const Unit&) const {}
};
__device__ __forceinline__ unsigned cvt_pk_bf16(float lo, float hi) { unsigned r; asm volatile("v_cvt_pk_bf16_f32 %0, %1, %2" : "=v"(r) : "v"(lo), "v"(hi)); return r; }
template <class Epi, class Sched, bool STAMP = false>
__device__ __forceinline__ void gemm_phase(PG8_LAS unsigned char* lds, const Gemm g, const Sched& S, const Epi& E, unsigned long long* stamps) {
    int tid_ = threadIdx.x; asm volatile("" : "+v"(tid_));
    const int tid = tid_, wid = __builtin_amdgcn_readfirstlane(tid >> 6), lane = tid & 63, wr = wid >> 2, wc = wid & 3, fr = lane & 15, fq = lane >> 4;
    const int K = g.K, nt = K / BK;
    unsigned voffA[2], voffB[2];
#pragma unroll
    for (int i = 0; i < 2; ++i) { int R, C; stage_rc(tid * 16 + i * 8192, R, C); const int Rb = Epi::PERM ? ((R & ~31) + perm32(R & 31)) : R;
        voffA[i] = (unsigned)(R * K + C) * 2u; voffB[i] = (unsigned)(Rb * K + C) * 2u; }
    const size_t kstep = (size_t)(BK * 2);
    const size_t hstep = (size_t)HALF * K * 2;
    const size_t tstep = 2 * hstep;
    const unsigned ldsw = (unsigned)wid * 1024u;
    const int aoff = lds_byte(wr * 64 + fr, fq * 8), boff = lds_byte(wc * 32 + fr, fq * 8);
#define PG8_SA(b, h) (((b) * 2 + (h)) * HTB)
#define PG8_SB(b, h) ((4 + (b) * 2 + (h)) * HTB)
#define PG8_STAGE(bufoff, gbase, voff) do { _Pragma("unroll") for (int _i = 0; _i < 2; ++_i) \
        __builtin_amdgcn_global_load_lds((const unsigned*)((const char*)(gbase) + (voff)[_i]), (PG8_LAS unsigned*)(lds + (bufoff) + ldsw + _i * 8192), 16, 0, 0); } while (0)
#define PG8_LDA(dst, b, h) do { _Pragma("unroll") for (int m = 0; m < 4; ++m) _Pragma("unroll") for (int k = 0; k < 2; ++k) dst[m][k] = *(const PG8_LAS bf16x8*)(lds + PG8_SA(b, h) + aoff + m * 2048 + k * 1024); } while (0)
#define PG8_LDB(dst, b, h) do { _Pragma("unroll") for (int n = 0; n < 2; ++n) _Pragma("unroll") for (int k = 0; k < 2; ++k) dst[n][k] = *(const PG8_LAS bf16x8*)(lds + PG8_SB(b, h) + boff + n * 2048 + k * 1024); } while (0)
#define PG8_MMA(ai, bj, At, Bt) do { __builtin_amdgcn_s_setprio(1); _Pragma("unroll") for (int m = 0; m < 4; ++m) _Pragma("unroll") for (int n = 0; n < 2; ++n) _Pragma("unroll") for (int k = 0; k < 2; ++k) \
        acc[ai][bj][m][n] = __builtin_amdgcn_mfma_f32_16x16x32_bf16(Bt[n][k], At[m][k], acc[ai][bj][m][n], 0, 0, 0); __builtin_amdgcn_s_setprio(0); } while (0)
#define PG8_WAIT_V(n) asm volatile("s_waitcnt vmcnt(" #n ")" ::: "memory")
#define PG8_WAIT_L(n) asm volatile("s_waitcnt lgkmcnt(" #n ")" ::: "memory")
#define PG8_BAR __builtin_amdgcn_s_barrier()
#define PG8_SCHED __builtin_amdgcn_sched_barrier(0)
    Unit cur, nxt; int ui = 0;
    if (!S.next(0, cur)) return;
    f32x4 acc[2][2][4][2];
#pragma unroll
    for (int a = 0; a < 2; ++a)
#pragma unroll
        for (int b = 0; b < 2; ++b)
#pragma unroll
            for (int m = 0; m < 4; ++m)
#pragma unroll
                for (int n = 0; n < 2; ++n) acc[a][b][m][n] = (f32x4){0.f, 0.f, 0.f, 0.f};
    bf16x8 At[4][2], B0[2][2], B1[2][2];
    const char* cA = (const char*)g.A + (size_t)cur.pm * tstep; const char* cB = (const char*)g.Bt + (size_t)cur.pn * tstep;
    S.a_ready(cur);
    PG8_STAGE(PG8_SB(0, 0), cB, voffB); PG8_STAGE(PG8_SA(0, 0), cA, voffA); PG8_STAGE(PG8_SB(0, 1), cB + hstep, voffB); PG8_STAGE(PG8_SA(0, 1), cA + hstep, voffA);
    if (wr == 1) PG8_BAR;
    PG8_WAIT_V(4); PG8_BAR;
    PG8_STAGE(PG8_SB(1, 0), cB + kstep, voffB); PG8_STAGE(PG8_SA(1, 0), cA + kstep, voffA); PG8_STAGE(PG8_SB(1, 1), cB + hstep + kstep, voffB);
    PG8_WAIT_V(6); PG8_BAR;
    for (;;) {
        const bool has_next = S.next(ui + 1, nxt);
        const char* nA = has_next ? (const char*)g.A + (size_t)nxt.pm * tstep : cA; const char* nB = has_next ? (const char*)g.Bt + (size_t)nxt.pn * tstep : cB;
        for (int t = 0; t < nt; t += 2) {
            const bool last = (t == nt - 2);
            const char* a1 = cA + (size_t)(t + 1) * kstep;
            const char* a2 = last ? nA : cA + (size_t)(t + 2) * kstep; const char* b2 = last ? nB : cB + (size_t)(t + 2) * kstep;
            const char* a3 = a2 + kstep; const char* b3 = b2 + kstep;
            if (last && has_next) S.a_ready(nxt);
            PG8_LDB(B0, 0, 0); PG8_SCHED; PG8_LDA(At, 0, 0); PG8_STAGE(PG8_SA(1, 1), a1 + hstep, voffA);
            PG8_WAIT_L(8); PG8_BAR; PG8_WAIT_L(0); PG8_MMA(0, 0, At, B0); PG8_BAR; PG8_SCHED;
            PG8_LDB(B1, 0, 1); PG8_STAGE(PG8_SB(0, 0), b2, voffB);
            PG8_BAR; PG8_WAIT_L(0); PG8_MMA(0, 1, At, B1); PG8_BAR;
            PG8_LDA(At, 0, 1); PG8_STAGE(PG8_SA(0, 0), a2, voffA);
            PG8_BAR; PG8_WAIT_L(0); PG8_MMA(1, 0, At, B0); PG8_BAR; PG8_SCHED;
            PG8_STAGE(PG8_SB(0, 1), b2 + hstep, voffB);
            PG8_WAIT_V(6); PG8_BAR; PG8_MMA(1, 1, At, B1); PG8_BAR;
            PG8_LDB(B0, 1, 0); PG8_SCHED; PG8_LDA(At, 1, 0); PG8_STAGE(PG8_SA(0, 1), a2 + hstep, voffA);
            PG8_WAIT_L(8); PG8_BAR; PG8_WAIT_L(0); PG8_MMA(0, 0, At, B0); PG8_BAR; PG8_SCHED;
            PG8_LDB(B1, 1, 1); PG8_STAGE(PG8_SB(1, 0), b3, voffB);
            PG8_BAR; PG8_WAIT_L(0); PG8_MMA(0, 1, At, B1); PG8_BAR;
            PG8_LDA(At, 1, 1); PG8_STAGE(PG8_SA(1, 0), a3, voffA);
            PG8_BAR; PG8_WAIT_L(0); PG8_MMA(1, 0, At, B0); PG8_BAR; PG8_SCHED;
            PG8_STAGE(PG8_SB(1, 1), b3 + hstep, voffB);
            PG8_WAIT_V(6); PG8_BAR; PG8_MMA(1, 1, At, B1); PG8_BAR;
        }
        if constexpr (!Epi::AFTER_DRAIN) { E(acc, cur, wr, wc, fr, fq); S.done(cur); }
        if (!has_next) break;
#pragma unroll
        for (int a = 0; a < 2; ++a)
#pragma unroll
            for (int b = 0; b < 2; ++b)
#pragma unroll
                for (int m = 0; m < 4; ++m)
#pragma unroll
                    for (int n = 0; n < 2; ++n) acc[a][b][m][n] = (f32x4){0.f, 0.f, 0.f, 0.f};
        cur = nxt; cA = nA; cB = nB; ++ui;
    }
    PG8_WAIT_V(0);
    if (wr == 0) PG8_BAR;
    PG8_BAR;
    if constexpr (Epi::AFTER_DRAIN) { E.fused(acc, cur, wr, wc, fr, fq, lds, wid, lane); S.done(cur); }
#undef PG8_SA
#undef PG8_SB
#undef PG8_STAGE
#undef PG8_LDA
#undef PG8_LDB
#undef PG8_MMA
#undef PG8_WAIT_V
#undef PG8_WAIT_L
#undef PG8_BAR
#undef PG8_SCHED
}
}
#ifndef CFG_B
#define CFG_B 4
#define CFG_T 2048
#define CFG_TC 256
#define CFG_D 2048
#define CFG_FF 5632
#define CFG_L 4
#endif
constexpr int B_ = CFG_B, T_ = CFG_T, TC_ = CFG_TC, D_ = CFG_D, FF_ = CFG_FF, L_ = CFG_L;
constexpr int NV = B_ + 1;
constexpr int MX = B_ * T_, MCX = B_ * TC_, MT = MX + MCX;
constexpr int NCH = MT / 64, XCH = T_ / 64, CCH = TC_ / 64, NSC = XCH + CCH;
constexpr int GW = 64, ROWS = T_ / GW;
constexpr int DIN = 7696, NP = 7680, NPAD = 7936, DMIX = 2048, D6 = 6 * D_, FF2 = 2 * FF_;
constexpr int NSW = 128 + TC_;
constexpr int KPARTS = 8;
constexpr float EPS_ = 1e-6f;
constexpr int A_Q = 0, A_I = 512, A_ZF = 1024, A_G = 2048;
constexpr int B_Q = 2560, B_V = 3584;
constexpr int C_Q = 4096, C_K = 4608, C_V = 5120;
constexpr int D_Q = 5632, D_K = 6144, D_V = 6656, D_O = 7168;

typedef unsigned short bf16_t;
DEV float bf2f(bf16_t b) { unsigned u = ((unsigned)b) << 16; float f; __builtin_memcpy(&f, &u, 4); return f; }
DEV bf16_t f2bf(float f) { unsigned u; __builtin_memcpy(&u, &f, 4); u += 0x7FFFu + ((u >> 16) & 1u); return (bf16_t)(u >> 16); }
DEV float sigmoidf_(float x) { return 1.0f / (1.0f + expf(-x)); }
DEV float siluf_(float x) { return x / (1.0f + expf(-x)); }
DEV float logsigf_(float x) { return x >= 0.f ? -log1pf(expf(-x)) : x - log1pf(expf(x)); }
DEV int imin(int a, int b) { return a < b ? a : b; }
DEV int imax(int a, int b) { return a > b ? a : b; }
DEV int iclip(int v, int lo, int hi) { return v < lo ? lo : (v > hi ? hi : v); }

#define WS_FIELDS(F) \
    F(ctl, unsigned, (size_t)1 << 16) \
    F(X, float, (size_t)MT * D_) \
    F(SC, float, NV * D_) \
    F(MODP, float, (size_t)L_ * KPARTS * NV * D6) \
    F(MOD, float, (size_t)L_ * NV * D6) \
    F(LBV, float, L_ * 2 * 512) \
    F(LAMF, float, 64) \
    F(PART, float, (size_t)MT * (D_ / 64)) \
    F(RSTD, float, MT) \
    F(G, float, (size_t)MT * 16) \
    F(Hb, bf16_t, (size_t)MT * D_) \
    F(Pb, bf16_t, (size_t)MT * NP) \
    F(QKB, bf16_t, (size_t)MT * 1024) \
    F(Y, bf16_t, (size_t)MT * DMIX) \
    F(U, bf16_t, (size_t)MT * FF2) \
    F(ACT, bf16_t, (size_t)MT * FF_) \
    F(QH, float, (size_t)MT * 512) \
    F(KK, float, (size_t)2 * MT * 512) \
    F(BC, float, (size_t)2 * MT * 512) \
    F(BL, float, (size_t)2 * NCH * 512) \
    F(HST, float, (size_t)2 * NCH * 4 * 16384) \
    F(HA, float, (size_t)2 * NCH * 4 * 4096) \
    F(HO, float, (size_t)2 * MT * 512) \
    F(MB, float, (size_t)2 * MT * 4) \
    F(MWU, float, (size_t)2 * MT * 4) \
    F(MLI, float, (size_t)2 * MT * 4) \
    F(MBL, float, (size_t)2 * NCH * 4) \
    F(MML, float, (size_t)2 * NCH * 4) \
    F(MMIN, float, (size_t)2 * NCH * 4) \
    F(MCs, float, (size_t)2 * NCH * 4 * 16384) \
    F(MN, float, (size_t)2 * NCH * 4 * 128) \
    F(MQK, float, (size_t)NCH * 4 * 4096) \
    F(MW, float, (size_t)2 * NCH * 4 * 4096) \
    F(MSC, float, (size_t)2 * MT * 4 * 2) \
    F(MH, float, (size_t)2 * MT * 512) \
    F(DO, float, (size_t)2 * MT * 512) \
    F(NS, float, (size_t)MT * 4 * NSW) \
    F(Wt_in, bf16_t, (size_t)L_ * NPAD * D_) \
    F(Wt_out, bf16_t, (size_t)L_ * D_ * DMIX) \
    F(Wt_up, bf16_t, (size_t)L_ * FF2 * D_) \
    F(Wt_down, bf16_t, (size_t)L_ * D_ * FF_)
enum WsId {
#define F(name, type, count) W_##name,
    WS_FIELDS(F)
#undef F
    W_COUNT };
constexpr size_t WS_BYTES[W_COUNT] = {
#define F(name, type, count) (size_t)(count) * sizeof(type),
    WS_FIELDS(F)
#undef F
};
constexpr size_t ws_off(int id) { size_t o = 0; for (int i = 0; i < id; ++i) o += (WS_BYTES[i] + 255) & ~(size_t)255; return o; }
constexpr size_t WS_TOTAL = ws_off(W_COUNT);
struct Ctx {
    const float *x_in, *c_in, *ctx_in, *c_ctx, *w_ada, *b_ada, *w_in, *hgrn_lb, *hgrn_norm_w, *diff_lam, *diff_norm_w, *na_rpb, *mlstm_f_bias, *mlstm_norm_w,
        *w_out, *w_up, *conv_w, *conv_b, *w_down, *final_norm_w;
    float* out;
    unsigned char* ws;
#define F(name, type, count) MDEV type* name() const { constexpr size_t o = ws_off(W_##name); return (type*)(ws + o); }
    WS_FIELDS(F)
#undef F
};

DEV int row_vec(int m) { return m < MX ? m / T_ : B_; }
DEV int row_batch(int m) { return m < MX ? m / T_ : (m - MX) / TC_; }
DEV int row_pos(int m) { return m < MX ? m % T_ : (m - MX) % TC_; }
DEV int row_len(int m) { return m < MX ? T_ : TC_; }
DEV int stream_chunk(int dir, int b, int i) {
    if (i < CCH) { const int cc = dir == 0 ? i : CCH - 1 - i; return (MX + b * TC_) / 64 + cc; }
    const int j = i - CCH, xc = dir == 0 ? j : XCH - 1 - j; return b * XCH + xc;
}
DEV int proc_row(int dir, int chunk, int j) { return chunk * 64 + (dir == 0 ? j : 63 - j); }
DEV int proc_idx(int dir, int m) { const int o = m & 63; return dir == 0 ? o : 63 - o; }

constexpr long N_P0 = (long)MT * D_ + NV * D_ + L_ * 2 * 512 + L_;
DEV void st_prologue(const Ctx& c, long i) {
    if (i < (long)MT * D_) { c.X()[i] = i < (long)MX * D_ ? c.x_in[i] : c.ctx_in[i - (long)MX * D_]; return; }
    i -= (long)MT * D_;
    if (i < NV * D_) { const int v = (int)(i / D_), k = (int)(i % D_); c.SC()[i] = siluf_(v < B_ ? c.c_in[v * D_ + k] : c.c_ctx[k]); return; }
    i -= NV * D_;
    if (i < L_ * 2 * 512) {
        const int l = (int)(i / 1024), rc = (int)(i % 1024);
        float mx = -1e30f; for (int j = 0; j < L_; ++j) mx = fmaxf(mx, c.hgrn_lb[j * 1024 + rc]);
        float den = 0.f, num = 0.f; for (int j = 0; j < L_; ++j) { const float e = expf(c.hgrn_lb[j * 1024 + rc] - mx); den += e; if (j >= 1 && j <= l) num += e; }
        c.LBV()[i] = num / den; return; }
    i -= L_ * 2 * 512;
    { const int l = (int)i; const float* lm = c.diff_lam + l * 4 * 64; float s1 = 0.f, s2 = 0.f;
      for (int d = 0; d < 64; ++d) { s1 += lm[d] * lm[64 + d]; s2 += lm[128 + d] * lm[192 + d]; }
      const float li = 0.8f - 0.6f * expf(-0.3f * (float)l);
      c.LAMF()[2 * l] = expf(s1) - expf(s2) + li; c.LAMF()[2 * l + 1] = li; }
}
constexpr long N_MODP = (long)L_ * KPARTS * D6;
DEV void st_modp(const Ctx& c, long i) {
    const int col = (int)(i % D6), kp = (int)((i / D6) % KPARTS), l = (int)(i / ((long)D6 * KPARTS));
    float acc[NV];
#pragma unroll
    for (int v = 0; v < NV; ++v) acc[v] = 0.f;
    const int k0 = kp * (D_ / KPARTS);
    for (int k = k0; k < k0 + D_ / KPARTS; ++k) { const float w = c.w_ada[((size_t)l * D_ + k) * D6 + col];
#pragma unroll
        for (int v = 0; v < NV; ++v) acc[v] += c.SC()[v * D_ + k] * w; }
#pragma unroll
    for (int v = 0; v < NV; ++v) c.MODP()[(((size_t)l * KPARTS + kp) * NV + v) * D6 + col] = acc[v];
}
constexpr long N_MODR = (long)L_ * NV * D6;
DEV void st_modr(const Ctx& c, long i) {
    const int col = (int)(i % D6), v = (int)((i / D6) % NV), l = (int)(i / ((long)D6 * NV));
    float s = c.b_ada[(size_t)l * D6 + col];
    for (int kp = 0; kp < KPARTS; ++kp) s += c.MODP()[(((size_t)l * KPARTS + kp) * NV + v) * D6 + col];
    c.MOD()[i] = s;
}

constexpr long N_SS = (long)MT * (D_ / 64);
DEV void st_sumsq(const Ctx& c, long i) { const float* p = c.X() + i * 64; float s = 0.f; for (int k = 0; k < 64; ++k) s += p[k] * p[k]; c.PART()[i] = s; }
DEV void st_rstd(const Ctx& c, long m) { float s = 0.f; for (int k = 0; k < D_ / 64; ++k) s += c.PART()[m * (D_ / 64) + k]; c.RSTD()[m] = 1.0f / sqrtf(s / (float)D_ + EPS_); }
DEV void st_mod(const Ctx& c, int l, int which, long i) {
    const int m = (int)(i / D_), col = (int)(i % D_); const float* md = c.MOD() + ((size_t)l * NV + row_vec(m)) * D6 + which * 3 * D_;
    c.Hb()[i] = f2bf(c.X()[i] * c.RSTD()[m] * (1.0f + md[D_ + col]) + md[col]);
}

DEV void st_a1(const Ctx& c, int l, long i) {
    const int m = (int)(i / 512), col = (int)(i % 512); const bf16_t* p = c.Pb() + (size_t)m * NP;
    c.QH()[i] = siluf_(bf2f(p[A_Q + col])) * 0.08838834764831845f;
    for (int dir = 0; dir < 2; ++dir) { const float z = bf2f(p[A_ZF + dir * 512 + col]), lb = c.LBV()[(l * 2 + dir) * 512 + col];
        const float kk = (1.0f - lb) * sigmoidf_(-z);
        c.KK()[((size_t)dir * MT + m) * 512 + col] = kk; c.BC()[((size_t)dir * MT + m) * 512 + col] = log1pf(-kk); }
}
DEV void st_a2(const Ctx& c, long i) {
    const int col = (int)(i % 512), chunk = (int)((i / 512) % NCH), dir = (int)(i / (512L * NCH)); float s = 0.f;
    for (int j = 0; j < 64; ++j) { float* p = c.BC() + ((size_t)dir * MT + proc_row(dir, chunk, j)) * 512 + col; s += *p; *p = s; }
    c.BL()[((size_t)dir * NCH + chunk) * 512 + col] = s;
}
DEV void st_a3(const Ctx& c, long i) {
    const int e = (int)(i & 127), d = (int)((i >> 7) & 127), h = (int)((i >> 14) & 3), chunk = (int)((i >> 16) % NCH), dir = (int)((i >> 16) / NCH);
    const float bl = c.BL()[((size_t)dir * NCH + chunk) * 512 + h * 128 + d]; float s = 0.f;
    for (int j = 0; j < 64; ++j) { const int m = chunk * 64 + j; const size_t o = ((size_t)dir * MT + m) * 512 + h * 128 + d;
        s += c.KK()[o] * expf(bl - c.BC()[o]) * bf2f(c.Pb()[(size_t)m * NP + A_I + h * 128 + e]); }
    c.HST()[i] = s;
}
DEV void st_a4(const Ctx& c, long i) {
    const int e = (int)(i & 127), d = (int)((i >> 7) & 127), h = (int)((i >> 14) & 3), b = (int)((i >> 16) % B_), dir = (int)((i >> 16) / B_);
    float S = 0.f;
    for (int s = 0; s < NSC; ++s) { const int chunk = stream_chunk(dir, b, s); float* p = c.HST() + (((size_t)dir * NCH + chunk) * 4 + h) * 16384 + d * 128 + e;
        const float t = *p; *p = S; S = expf(c.BL()[((size_t)dir * NCH + chunk) * 512 + h * 128 + d]) * S + t; }
}
DEV void st_a5(const Ctx& c, long i) {
    const int s = (int)(i & 63), t = (int)((i >> 6) & 63), h = (int)((i >> 12) & 3), chunk = (int)((i >> 14) % NCH), dir = (int)((i >> 14) / NCH);
    float a = 0.f;
    if (s <= t) { const size_t ot = ((size_t)dir * MT + proc_row(dir, chunk, t)) * 512 + h * 128, os = ((size_t)dir * MT + proc_row(dir, chunk, s)) * 512 + h * 128;
        const float* q = c.QH() + (size_t)proc_row(dir, chunk, t) * 512 + h * 128;
        for (int d = 0; d < 128; ++d) a += q[d] * c.KK()[os + d] * expf(c.BC()[ot + d] - c.BC()[os + d]); }
    c.HA()[i] = a;
}
DEV void st_a6(const Ctx& c, long i) {
    const int col = (int)(i % 512), m = (int)((i / 512) % MT), dir = (int)(i / (512L * MT)), h = col >> 7, e = col & 127, chunk = m >> 6, t = proc_idx(dir, m);
    const float* S = c.HST() + (((size_t)dir * NCH + chunk) * 4 + h) * 16384; const float* q = c.QH() + (size_t)m * 512 + h * 128; const float* bc = c.BC() + ((size_t)dir * MT + m) * 512 + h * 128;
    float o = 0.f;
    for (int d = 0; d < 128; ++d) o += q[d] * expf(bc[d]) * S[d * 128 + e];
    const float* A = c.HA() + ((((size_t)dir * NCH + chunk) * 4 + h) * 64 + t) * 64;
    for (int s = 0; s <= t; ++s) o += A[s] * bf2f(c.Pb()[(size_t)proc_row(dir, chunk, s) * NP + A_I + col]);
    c.HO()[i] = o;
}
DEV void st_a7(const Ctx& c, int l, long i) {
    const int h = (int)(i & 3), m = (int)(i >> 2); const float* o0 = c.HO() + (size_t)m * 512 + h * 128; const float* o1 = o0 + (size_t)MT * 512;
    float ss = 0.f; for (int e = 0; e < 128; ++e) { const float o = o0[e] + o1[e]; ss += o * o; }
    const float r = 1.0f / sqrtf(ss / 128.f + EPS_);
    for (int e = 0; e < 128; ++e) c.Y()[(size_t)m * DMIX + h * 128 + e] = f2bf((o0[e] + o1[e]) * r * c.hgrn_norm_w[l * 512 + h * 128 + e] * siluf_(bf2f(c.Pb()[(size_t)m * NP + A_G + h * 128 + e])));
}

DEV void st_d2(const Ctx& c, int l, long i) {
    const int h = (int)(i & 3), chunk = (int)((i >> 2) % NCH), dir = (int)((i >> 2) / NCH); const float fb = c.mlstm_f_bias[(l * 2 + dir) * 4 + h];
    float s = 0.f;
    for (int j = 0; j < 64; ++j) { const int m = proc_row(dir, chunk, j); const float* g = c.G() + (size_t)m * 16;
        s += logsigf_(g[(2 * dir + 1) * 4 + h] + fb); c.MB()[((size_t)dir * MT + m) * 4 + h] = s; c.MLI()[((size_t)dir * MT + m) * 4 + h] = g[(2 * dir) * 4 + h]; }
    float mx = -1e30f;
    for (int j = 0; j < 64; ++j) { const size_t o = ((size_t)dir * MT + chunk * 64 + j) * 4 + h; mx = fmaxf(mx, s - c.MB()[o] + c.MLI()[o]); }
    for (int j = 0; j < 64; ++j) { const size_t o = ((size_t)dir * MT + chunk * 64 + j) * 4 + h; c.MWU()[o] = expf(s - c.MB()[o] + c.MLI()[o] - mx); }
    c.MBL()[((size_t)dir * NCH + chunk) * 4 + h] = s; c.MML()[((size_t)dir * NCH + chunk) * 4 + h] = mx;
}
DEV void st_d3(const Ctx& c, long i) {
    const int e = (int)(i & 127), d = (int)((i >> 7) & 127), h = (int)((i >> 14) & 3), chunk = (int)((i >> 16) % NCH), dir = (int)((i >> 16) / NCH);
    float s = 0.f, sn = 0.f;
    for (int j = 0; j < 64; ++j) { const int m = chunk * 64 + j; const bf16_t* p = c.Pb() + (size_t)m * NP; const float wk = c.MWU()[((size_t)dir * MT + m) * 4 + h] * bf2f(p[D_K + h * 128 + d]);
        s += wk * bf2f(p[D_V + h * 128 + e]); sn += wk; }
    c.MCs()[i] = s; if (e == 0) c.MN()[(((size_t)dir * NCH + chunk) * 4 + h) * 128 + d] = sn;
}
DEV void st_d4(const Ctx& c, long i) {
    const int e = (int)(i & 127), d = (int)((i >> 7) & 127), h = (int)((i >> 14) & 3), b = (int)((i >> 16) % B_), dir = (int)((i >> 16) / B_);
    float C = 0.f, n = 0.f, mm = 0.f;
    for (int s = 0; s < NSC; ++s) { const int chunk = stream_chunk(dir, b, s); const size_t oc = ((size_t)dir * NCH + chunk) * 4 + h;
        const float bl = c.MBL()[oc], ml = c.MML()[oc], mn = fmaxf(bl + mm, ml), ws = expf(bl + mm - mn), wl = expf(ml - mn);
        float* p = c.MCs() + oc * 16384 + d * 128 + e; const float t = *p; *p = C; C = ws * C + wl * t;
        if (e == 0) { float* pn = c.MN() + oc * 128 + d; const float tn = *pn; *pn = n; n = ws * n + wl * tn; if (d == 0) c.MMIN()[oc] = mm; }
        mm = mn; }
}
DEV void st_d5(const Ctx& c, long i) {
    const int s = (int)(i & 63), t = (int)((i >> 6) & 63), h = (int)((i >> 12) & 3), chunk = (int)(i >> 14);
    const bf16_t* q = c.Pb() + (size_t)(chunk * 64 + t) * NP + D_Q + h * 128; const bf16_t* k = c.Pb() + (size_t)(chunk * 64 + s) * NP + D_K + h * 128;
    float a = 0.f; for (int d = 0; d < 128; ++d) a += bf2f(q[d]) * bf2f(k[d]);
    c.MQK()[i] = a * 0.08838834764831845f;
}
DEV void st_d6(const Ctx& c, long i) {
    const int h = (int)(i & 3), m = (int)((i >> 2) % MT), dir = (int)((i >> 2) / MT), chunk = m >> 6, t = proc_idx(dir, m);
    const size_t oc = ((size_t)dir * NCH + chunk) * 4 + h; const float bt = c.MB()[((size_t)dir * MT + m) * 4 + h], inter = bt + c.MMIN()[oc];
    float mt = inter;
    for (int s = 0; s <= t; ++s) { const size_t o = ((size_t)dir * MT + proc_row(dir, chunk, s)) * 4 + h; mt = fmaxf(mt, bt - c.MB()[o] + c.MLI()[o]); }
    const float wi = expf(inter - mt);
    float* W = c.MW() + (oc * 64 + t) * 64; float sw = 0.f;
    for (int s = 0; s < 64; ++s) { float w = 0.f;
        if (s <= t) { const int ms = proc_row(dir, chunk, s); const size_t o = ((size_t)dir * MT + ms) * 4 + h;
            w = expf(bt - c.MB()[o] + c.MLI()[o] - mt) * c.MQK()[(((size_t)chunk * 4 + h) * 64 + (m & 63)) * 64 + (ms & 63)]; }
        W[s] = w; sw += w; }
    const bf16_t* q = c.Pb() + (size_t)m * NP + D_Q + h * 128; const float* nin = c.MN() + oc * 128; float qn = 0.f;
    for (int d = 0; d < 128; ++d) qn += bf2f(q[d]) * nin[d];
    const float den = wi * qn * 0.08838834764831845f + sw;
    c.MSC()[(((size_t)dir * MT + m) * 4 + h) * 2] = wi * 0.08838834764831845f; c.MSC()[(((size_t)dir * MT + m) * 4 + h) * 2 + 1] = 1.0f / fmaxf(fabsf(den), expf(-mt));
}
DEV void st_d7(const Ctx& c, long i) {
    const int col = (int)(i % 512), m = (int)((i / 512) % MT), dir = (int)(i / (512L * MT)), h = col >> 7, e = col & 127, chunk = m >> 6, t = proc_idx(dir, m);
    const size_t oc = ((size_t)dir * NCH + chunk) * 4 + h; const float* Cin = c.MCs() + oc * 16384; const bf16_t* q = c.Pb() + (size_t)m * NP + D_Q + h * 128;
    float a = 0.f; for (int d = 0; d < 128; ++d) a += bf2f(q[d]) * Cin[d * 128 + e];
    const float* sc = c.MSC() + (((size_t)dir * MT + m) * 4 + h) * 2; float num = sc[0] * a;
    const float* W = c.MW() + (oc * 64 + t) * 64;
    for (int s = 0; s <= t; ++s) num += W[s] * bf2f(c.Pb()[(size_t)proc_row(dir, chunk, s) * NP + D_V + col]);
    c.MH()[i] = num * sc[1];
}
DEV void st_d8(const Ctx& c, int l, long i) {
    const int h = (int)(i & 3), m = (int)(i >> 2); const float* h0 = c.MH() + (size_t)m * 512 + h * 128; const float* h1 = h0 + (size_t)MT * 512; const bf16_t* og = c.Pb() + (size_t)m * NP + D_O + h * 128;
    float ss = 0.f; for (int e = 0; e < 128; ++e) { const float v = sigmoidf_(bf2f(og[e])) * (h0[e] + h1[e]); ss += v * v; }
    const float r = 1.0f / sqrtf(ss / 128.f + EPS_);
    for (int e = 0; e < 128; ++e) c.Y()[(size_t)m * DMIX + 1536 + h * 128 + e] = f2bf(sigmoidf_(bf2f(og[e])) * (h0[e] + h1[e]) * r * c.mlstm_norm_w[l * 512 + h * 128 + e]);
}

DEV void st_b1(const Ctx& c, long i) {
    const int pr = (int)(i & 31), blk = (int)((i >> 5) & 7), which = (int)((i >> 8) & 1), m = (int)(i >> 9);
    const int ii = pr & 15, base = which * 512 + blk * 64 + (pr < 16 ? 0 : 32) + ii; const bf16_t* p = c.Pb() + (size_t)m * NP + B_Q;
    const float va = bf2f(p[base]), vb = bf2f(p[base + 16]); float oa = va, ob = vb;
    if (m < MX) { const int t = m % T_, pos = pr < 16 ? t / GW : t % GW; const float inv = powf(10000.0f, -(float)(2 * ii) / 32.0f), ang = (float)pos * inv, cs = cosf(ang), sn = sinf(ang);
        oa = va * cs - vb * sn; ob = vb * cs + va * sn; }
    c.QKB()[(size_t)m * 1024 + base] = f2bf(oa); c.QKB()[(size_t)m * 1024 + base + 16] = f2bf(ob);
}
DEV void st_b2(const Ctx& c, int ctx_out, long i) {
    const int hf = (int)(i & 3), map = (int)((i >> 2) & 1), h = (int)((i >> 3) & 3), m = (int)(i >> 5);
    if (m >= MX && !ctx_out) return;
    const int b = row_batch(m); float q[64];
#pragma unroll
    for (int d = 0; d < 64; ++d) q[d] = bf2f(c.QKB()[(size_t)m * 1024 + h * 128 + map * 64 + d]) * 0.125f;
    const int nlat = m < MX ? T_ : 0, nk = nlat + TC_;
    float mx = -1e30f, acc[32], den = 0.f;
#pragma unroll
    for (int e = 0; e < 32; ++e) acc[e] = 0.f;
    for (int j = 0; j < nk; ++j) { const int r = j < nlat ? b * T_ + j : MX + b * TC_ + (j - nlat); const bf16_t* k = c.QKB() + (size_t)r * 1024 + 512 + h * 128 + map * 64; float s = 0.f;
#pragma unroll
        for (int d = 0; d < 64; ++d) s += q[d] * bf2f(k[d]);
        if (s > mx) { const float f = expf(mx - s); den *= f;
#pragma unroll
            for (int e = 0; e < 32; ++e) acc[e] *= f;
            mx = s; }
        const float pz = expf(s - mx); den += pz; const bf16_t* v = c.Pb() + (size_t)r * NP + B_V + h * 128 + hf * 32;
#pragma unroll
        for (int e = 0; e < 32; ++e) acc[e] += pz * bf2f(v[e]); }
    const float rd = 1.0f / den; float* o = c.DO() + ((size_t)map * MT + m) * 512 + h * 128 + hf * 32;
#pragma unroll
    for (int e = 0; e < 32; ++e) o[e] = acc[e] * rd;
}
DEV void st_b3(const Ctx& c, int l, long i) {
    const int h = (int)(i & 3), m = (int)(i >> 2); const float lamf = c.LAMF()[2 * l], li = c.LAMF()[2 * l + 1];
    const float* o0 = c.DO() + (size_t)m * 512 + h * 128; const float* o1 = o0 + (size_t)MT * 512;
    float ss = 0.f; for (int e = 0; e < 128; ++e) { const float v = o0[e] - lamf * o1[e]; ss += v * v; }
    const float r = 1.0f / sqrtf(ss / 128.f + EPS_);
    for (int e = 0; e < 128; ++e) c.Y()[(size_t)m * DMIX + 512 + h * 128 + e] = f2bf((o0[e] - lamf * o1[e]) * r * c.diff_norm_w[l * 512 + h * 128 + e] * (1.0f - li));
}

DEV int na_key_row(int m, int j, int& roff, int& coff) {
    const int b = m / T_, t = m % T_, r = t / GW, wq = t % GW;
    if (j >= 128) { roff = -1; coff = -1; return MX + b * TC_ + (j - 128); }
    const int rs = iclip(r - 4, 0, ROWS - 8), cs = iclip(wq - 8, 0, GW - 16), kr = rs + (j >> 4), kc = cs + (j & 15);
    roff = kr - r + 7; coff = iclip(kc - wq, -15, 15) + 15; return b * T_ + kr * GW + kc;
}
DEV void st_c1(const Ctx& c, int l, long i) {
    const int j = (int)(i % NSW), h = (int)((i / NSW) & 3), m = (int)(i / (4L * NSW));
    int kr, roff = -1, coff = -1;
    if (m < MX) kr = na_key_row(m, j, roff, coff); else { if (j >= TC_) return; kr = MX + row_batch(m) * TC_ + j; }
    const bf16_t* q = c.Pb() + (size_t)m * NP + C_Q + h * 128; const bf16_t* k = c.Pb() + (size_t)kr * NP + C_K + h * 128;
    float s = 0.f; for (int d = 0; d < 128; ++d) s += bf2f(q[d]) * bf2f(k[d]);
    s *= 0.08838834764831845f;
    if (roff >= 0) s += c.na_rpb[((l * 4 + h) * 15 + roff) * 31 + coff];
    c.NS()[i] = s;
}
DEV void st_c2(const Ctx& c, long i) {
    const int m = (int)(i >> 2); const int n = m < MX ? NSW : TC_; float* s = c.NS() + i * NSW;
    float mx = -1e30f; for (int j = 0; j < n; ++j) mx = fmaxf(mx, s[j]);
    float den = 0.f; for (int j = 0; j < n; ++j) { const float e = expf(s[j] - mx); s[j] = e; den += e; }
    const float r = 1.0f / den; for (int j = 0; j < n; ++j) s[j] *= r;
}
DEV void st_c3(const Ctx& c, long i) {
    const int col = (int)(i % 512), m = (int)(i / 512), h = col >> 7; const float* p = c.NS() + ((size_t)m * 4 + h) * NSW; float o = 0.f;
    if (m < MX) { for (int j = 0; j < NSW; ++j) { int ro, co; const int kr = na_key_row(m, j, ro, co); o += p[j] * bf2f(c.Pb()[(size_t)kr * NP + C_V + col]); } }
    else { const int b = row_batch(m); for (int j = 0; j < TC_; ++j) o += p[j] * bf2f(c.Pb()[(size_t)(MX + b * TC_ + j) * NP + C_V + col]); }
    c.Y()[(size_t)m * DMIX + 1024 + col] = f2bf(o);
}

DEV void st_conv(const Ctx& c, int l, long i) {
    const int j = (int)(i % FF_), m = (int)(i / FF_), pos = row_pos(m), len = row_len(m); float v[2];
#pragma unroll
    for (int hf = 0; hf < 2; ++hf) { const int cc = hf * FF_ + j; float s = c.conv_b[(size_t)l * FF2 + cc];
        for (int dt = -1; dt <= 1; ++dt) if (pos + dt >= 0 && pos + dt < len) s += c.conv_w[((size_t)l * 3 + dt + 1) * FF2 + cc] * bf2f(c.U()[(size_t)(m + dt) * FF2 + cc]);
        v[hf] = s; }
    c.ACT()[i] = f2bf(siluf_(v[0]) * v[1]);
}
DEV void st_final(const Ctx& c, long i) { const int m = (int)(i / D_), col = (int)(i % D_); c.out[i] = c.X()[i] * c.RSTD()[m] * c.final_norm_w[col]; }
constexpr int PH_PRO = 3, PH_LAYER = 17, PH_FIN = 3, NPH = PH_PRO + L_ * PH_LAYER + PH_FIN;
constexpr int LDS_BYTES = 147456, MISC_OFF = 131072;
constexpr int CW_BAR = 1024;

struct EpiP {
    static constexpr bool PERM = true, AFTER_DRAIN = false;
    bf16_t* P; float* G;
    __device__ __forceinline__ void operator()(const pg8::f32x4 (&acc)[2][2][4][2], const pg8::Unit& u, int wr, int wc, int fr, int fq) const {
        const int row0 = u.pm * 256 + wr * 64 + fr;
        if (u.pn < NP / 256) {
            const int col0 = u.pn * 256 + wc * 32 + 8 * fq;
#pragma unroll
            for (int ai = 0; ai < 2; ++ai)
#pragma unroll
                for (int m = 0; m < 4; ++m) { bf16_t* rowp = P + (size_t)(row0 + ai * 128 + m * 16) * NP + col0;
#pragma unroll
                    for (int bj = 0; bj < 2; ++bj) { const pg8::f32x4 v0 = acc[ai][bj][m][0], v1 = acc[ai][bj][m][1];
                        pg8::u32x4 w; w.x = pg8::cvt_pk_bf16(v0[0], v0[1]); w.y = pg8::cvt_pk_bf16(v0[2], v0[3]); w.z = pg8::cvt_pk_bf16(v1[0], v1[1]); w.w = pg8::cvt_pk_bf16(v1[2], v1[3]);
                        *(pg8::u32x4*)(rowp + bj * 128) = w; } }
        } else if (wc == 0 && fq < 2) {
#pragma unroll
            for (int ai = 0; ai < 2; ++ai)
#pragma unroll
                for (int m = 0; m < 4; ++m) { float* rowp = G + (size_t)(row0 + ai * 128 + m * 16) * 16 + 8 * fq;
                    *(pg8::f32x4*)(rowp) = acc[ai][0][m][0]; *(pg8::f32x4*)(rowp + 4) = acc[ai][0][m][1]; }
        }
    }
};
struct EpiU {
    static constexpr bool PERM = true, AFTER_DRAIN = false;
    bf16_t* O;
    __device__ __forceinline__ void operator()(const pg8::f32x4 (&acc)[2][2][4][2], const pg8::Unit& u, int wr, int wc, int fr, int fq) const {
        const int row0 = u.pm * 256 + wr * 64 + fr, col0 = u.pn * 256 + wc * 32 + 8 * fq;
#pragma unroll
        for (int ai = 0; ai < 2; ++ai)
#pragma unroll
            for (int m = 0; m < 4; ++m) { bf16_t* rowp = O + (size_t)(row0 + ai * 128 + m * 16) * FF2 + col0;
#pragma unroll
                for (int bj = 0; bj < 2; ++bj) { const pg8::f32x4 v0 = acc[ai][bj][m][0], v1 = acc[ai][bj][m][1];
                    pg8::u32x4 w; w.x = pg8::cvt_pk_bf16(v0[0], v0[1]); w.y = pg8::cvt_pk_bf16(v0[2], v0[3]); w.z = pg8::cvt_pk_bf16(v1[0], v1[1]); w.w = pg8::cvt_pk_bf16(v1[2], v1[3]);
                    *(pg8::u32x4*)(rowp + bj * 128) = w; } }
    }
};
struct EpiRes {
    static constexpr bool PERM = false, AFTER_DRAIN = false;
    float* X; const float* gate;
    __device__ __forceinline__ void operator()(const pg8::f32x4 (&acc)[2][2][4][2], const pg8::Unit& u, int wr, int wc, int fr, int fq) const {
        const int row0 = u.pm * 256 + wr * 64 + fr, col0 = u.pn * 256 + wc * 32 + 4 * fq;
#pragma unroll
        for (int ai = 0; ai < 2; ++ai)
#pragma unroll
            for (int m = 0; m < 4; ++m) { const int row = row0 + ai * 128 + m * 16; float* rowp = X + (size_t)row * D_ + col0; const float* gp = gate + (size_t)row_vec(row) * D6 + col0;
#pragma unroll
                for (int bj = 0; bj < 2; ++bj)
#pragma unroll
                    for (int n = 0; n < 2; ++n) { const pg8::f32x4 gv = *(const pg8::f32x4*)(gp + bj * 128 + n * 16); pg8::f32x4* xp = (pg8::f32x4*)(rowp + bj * 128 + n * 16); *xp = *xp + gv * acc[ai][bj][m][n]; } }
    }
};

__device__ __forceinline__ void convert_tile(const float* src, int ldsrc, int nsrc, bf16_t* dst, int K, int k0, int n0, LAS float* tile) {
    const int tid = threadIdx.x;
    for (int e = tid; e < 4096; e += 512) { const int kk = e >> 6, nn = e & 63, n = n0 + nn; tile[kk * 65 + nn] = n < nsrc ? src[(size_t)(k0 + kk) * ldsrc + n] : 0.f; }
    __syncthreads();
    for (int e = tid; e < 4096; e += 512) { const int nn = e >> 6, kk = e & 63; dst[(size_t)(n0 + nn) * K + k0 + kk] = f2bf(tile[kk * 65 + nn]); }
    __syncthreads();
}
__device__ __forceinline__ void convert_weights(const Ctx& c, LAS float* tile) {
    constexpr int T_IN = (D_ / 64) * (NPAD / 64), T_OUT = (DMIX / 64) * (D_ / 64), T_UP = (D_ / 64) * (FF2 / 64), T_DN = (FF_ / 64) * (D_ / 64), T_L = T_IN + T_OUT + T_UP + T_DN;
    for (int t = blockIdx.x; t < L_ * T_L; t += gridDim.x) {
        const int l = t / T_L; int r = t % T_L;
        if (r < T_IN) { const int kt = r / (NPAD / 64), nt = r % (NPAD / 64); convert_tile(c.w_in + (size_t)l * D_ * DIN, DIN, DIN, c.Wt_in() + (size_t)l * NPAD * D_, D_, kt * 64, nt * 64, tile); continue; }
        r -= T_IN;
        if (r < T_OUT) { const int kt = r / (D_ / 64), nt = r % (D_ / 64); convert_tile(c.w_out + (size_t)l * DMIX * D_, D_, D_, c.Wt_out() + (size_t)l * D_ * DMIX, DMIX, kt * 64, nt * 64, tile); continue; }
        r -= T_OUT;
        if (r < T_UP) { const int kt = r / (FF2 / 64), nt = r % (FF2 / 64); convert_tile(c.w_up + (size_t)l * D_ * FF2, FF2, FF2, c.Wt_up() + (size_t)l * FF2 * D_, D_, kt * 64, nt * 64, tile); continue; }
        r -= T_UP;
        { const int kt = r / (D_ / 64), nt = r % (D_ / 64); convert_tile(c.w_down + (size_t)l * FF_ * D_, D_, D_, c.Wt_down() + (size_t)l * D_ * FF_, FF_, kt * 64, nt * 64, tile); }
    }
}

struct Args { const float* in[20]; float* out; unsigned char* ws; int ph_lo, ph_hi; };

#define IN_(k) (lo <= (k) && (k) < hi)
#define BAR_IF if (ph + 1 < hi) xcd_barrier(bar);
#define PROGRAM_HEAD
#define PH_BEGIN if (IN_(ph)) {
#define SEG(N, CALL) { Ctx c = c0; asm volatile("" : "+s"(c.ws)); unsigned t0_ = threadIdx.x; asm volatile("" : "+v"(t0_)); for (long i = (long)blockIdx.x * 512 + t0_; i < (long)(N); i += gsz) { CALL; } }
#define PH_END BAR_IF } ++ph;
#define CONVERT_WEIGHTS convert_weights(c, (LAS float*)ldsp);
#define GEMM_IN(l) if (IN_(ph)) { pg8::Gemm g{c.Hb(), c.Wt_in() + (size_t)(l) * NPAD * D_, MT, NPAD, D_}; pg8::StaticOrder S; S.init(MT, NPAD, (int)gridDim.x, (int)blockIdx.x); \
    EpiP E{c.Pb(), c.G()}; pg8::gemm_phase<EpiP, pg8::StaticOrder>(ldsp, g, S, E, nullptr); BAR_IF } ++ph;
#define GEMM_OUT(l, mr) if (IN_(ph)) { pg8::Gemm g{c.Y(), c.Wt_out() + (size_t)(l) * D_ * DMIX, mr, D_, DMIX}; pg8::StaticOrder S; S.init(mr, D_, (int)gridDim.x, (int)blockIdx.x); \
    EpiRes E{c.X(), c.MOD() + (size_t)(l) * NV * D6 + 2 * D_}; pg8::gemm_phase<EpiRes, pg8::StaticOrder>(ldsp, g, S, E, nullptr); BAR_IF } ++ph;
#define GEMM_UP(l, mr) if (IN_(ph)) { pg8::Gemm g{c.Hb(), c.Wt_up() + (size_t)(l) * FF2 * D_, mr, FF2, D_}; pg8::StaticOrder S; S.init(mr, FF2, (int)gridDim.x, (int)blockIdx.x); \
    EpiU E{c.U()}; pg8::gemm_phase<EpiU, pg8::StaticOrder>(ldsp, g, S, E, nullptr); BAR_IF } ++ph;
#define GEMM_DOWN(l, mr) if (IN_(ph)) { pg8::Gemm g{c.ACT(), c.Wt_down() + (size_t)(l) * D_ * FF_, mr, D_, FF_}; pg8::StaticOrder S; S.init(mr, D_, (int)gridDim.x, (int)blockIdx.x); \
    EpiRes E{c.X(), c.MOD() + (size_t)(l) * NV * D6 + 5 * D_}; pg8::gemm_phase<EpiRes, pg8::StaticOrder>(ldsp, g, S, E, nullptr); BAR_IF } ++ph;

__global__ void __launch_bounds__(512, 2) mega(Args a) {
    extern __shared__ __attribute__((aligned(16))) unsigned char lds[];
    PG8_LAS unsigned char* ldsp = (PG8_LAS unsigned char*)lds;
    Ctx c0;
    { Ctx& c = c0;
    c.x_in = a.in[0]; c.c_in = a.in[1]; c.ctx_in = a.in[2]; c.c_ctx = a.in[3]; c.w_ada = a.in[4]; c.b_ada = a.in[5]; c.w_in = a.in[6]; c.hgrn_lb = a.in[7]; c.hgrn_norm_w = a.in[8];
    c.diff_lam = a.in[9]; c.diff_norm_w = a.in[10]; c.na_rpb = a.in[11]; c.mlstm_f_bias = a.in[12]; c.mlstm_norm_w = a.in[13]; c.w_out = a.in[14]; c.w_up = a.in[15]; c.conv_w = a.in[16];
    c.conv_b = a.in[17]; c.w_down = a.in[18]; c.final_norm_w = a.in[19]; c.out = a.out;
    c.ws = a.ws; }
    const Ctx& c = c0;
    volatile LAS unsigned* misc = (volatile LAS unsigned*)(ldsp + MISC_OFF);
    if (threadIdx.x < 4) misc[threadIdx.x] = 0u;
    __syncthreads();
    const int lo = a.ph_lo, hi = a.ph_hi;
    XcdBarrier bar; bar.bar = c.ctl() + CW_BAR; bar.x = 0; bar.st = misc;
    if (hi - lo > 1) bar = xcd_barrier_post(c.ctl() + CW_BAR, misc);
    const long gsz = (long)gridDim.x * 512;
    int ph = 0;
PROGRAM_HEAD
{
    PH_BEGIN SEG(N_P0, st_prologue(c, i)) CONVERT_WEIGHTS PH_END
    PH_BEGIN SEG(N_MODP, st_modp(c, i)) PH_END
    PH_BEGIN SEG(N_MODR, st_modr(c, i)) PH_END
    for (int l = 0; l < L_; ++l) {
        const int ctx_out = l < L_ - 1; const int mrows = ctx_out ? MT : MX;
        PH_BEGIN SEG(N_SS, st_sumsq(c, i)) PH_END
        PH_BEGIN SEG(MT, st_rstd(c, i)) PH_END
        PH_BEGIN SEG((long)MT * D_, st_mod(c, l, 0, i)) PH_END
        GEMM_IN(l)
        PH_BEGIN SEG((long)MT * 512, st_a1(c, l, i)) SEG(2L * NCH * 4, st_d2(c, l, i)) SEG((long)MT * 512, st_b1(c, i)) SEG((long)NCH * 4 * 4096, st_d5(c, i)) SEG((long)MT * 4 * NSW, st_c1(c, l, i)) PH_END
        PH_BEGIN SEG((long)MT * 32, st_b2(c, ctx_out, i)) SEG(2L * NCH * 512, st_a2(c, i)) SEG(2L * NCH * 4 * 16384, st_d3(c, i)) SEG((long)MT * 4, st_c2(c, i)) PH_END
        PH_BEGIN SEG(2L * NCH * 4 * 16384, st_a3(c, i)) SEG(2L * B_ * 4 * 16384, st_d4(c, i)) SEG((long)MT * 512, st_c3(c, i)) PH_END
        PH_BEGIN SEG(2L * B_ * 4 * 16384, st_a4(c, i)) SEG(2L * NCH * 4 * 4096, st_a5(c, i)) SEG(2L * MT * 4, st_d6(c, i)) PH_END
        PH_BEGIN SEG(2L * MT * 512, st_a6(c, i)) SEG(2L * MT * 512, st_d7(c, i)) PH_END
        PH_BEGIN SEG((long)MT * 4, st_a7(c, l, i)) SEG((long)MT * 4, st_d8(c, l, i)) SEG((long)MT * 4, st_b3(c, l, i)) PH_END
        GEMM_OUT(l, mrows)
        PH_BEGIN SEG(N_SS, st_sumsq(c, i)) PH_END
        PH_BEGIN SEG(MT, st_rstd(c, i)) PH_END
        PH_BEGIN SEG((long)MT * D_, st_mod(c, l, 1, i)) PH_END
        GEMM_UP(l, mrows)
        PH_BEGIN SEG((long)mrows * FF_, st_conv(c, l, i)) PH_END
        GEMM_DOWN(l, mrows)
    }
    PH_BEGIN SEG(N_SS, st_sumsq(c, i)) PH_END
    PH_BEGIN SEG(MT, st_rstd(c, i)) PH_END
    PH_BEGIN SEG((long)MX * D_, st_final(c, i)) PH_END
}
}

extern "C" void kernel_launch(void* const* d_in, const int* in_sizes, int n_in, void* d_out, int out_size, void* d_ws, size_t ws_size, hipStream_t stream) {
    static int grid = 0;
    if (grid == 0) {
        const size_t need = WS_TOTAL;
        if (n_in != 20 || out_size != MX * D_ || ws_size < need) { fprintf(stderr, "kernel_launch: unexpected shapes (n_in %d, out %d, ws %zu, need %zu)\n", n_in, out_size, ws_size, need); grid = -1; return; }
        int dev = 0, cus = 0, per_cu = 0;
        if (hipGetDevice(&dev) != hipSuccess || hipDeviceGetAttribute(&cus, hipDeviceAttributeMultiprocessorCount, dev) != hipSuccess) { grid = -1; return; }
        if (hipFuncSetAttribute((const void*)mega, hipFuncAttributeMaxDynamicSharedMemorySize, LDS_BYTES) != hipSuccess) { fprintf(stderr, "kernel_launch: hipFuncSetAttribute failed\n"); grid = -1; return; }
        if (hipOccupancyMaxActiveBlocksPerMultiprocessor(&per_cu, (const void*)mega, 512, LDS_BYTES) != hipSuccess || per_cu < 1) fprintf(stderr, "kernel_launch: occupancy query says %d\n", per_cu);
        (void)hipGetLastError();
        grid = cus;
    }
    if (grid < 0) return;
    (void)hipMemsetAsync(d_ws, 0, (size_t)(1 << 16) * sizeof(unsigned), stream);
    Args a{};
    for (int i = 0; i < 20; ++i) a.in[i] = (const float*)d_in[i];
    a.out = (float*)d_out; a.ws = (unsigned char*)d_ws;
#if ONE_LAUNCH
    a.ph_lo = 0; a.ph_hi = NPH;
    hipLaunchKernelGGL(mega, dim3(grid), dim3(512), LDS_BYTES, stream, a);
#else
    for (int p = 0; p < NPH; ++p) { a.ph_lo = p; a.ph_hi = p + 1; hipLaunchKernelGGL(mega, dim3(grid), dim3(512), LDS_BYTES, stream, a); }
#endif
}
```

```cpp
#include <hip/hip_runtime.h>
#include <cstdio>
#include <cstdint>
#include <cstddef>
#define DEV __device__ __forceinline__
#define HD __host__ __device__
#define MDEV __device__ __forceinline__
#ifndef ONE_LAUNCH
#define ONE_LAUNCH 1
#endif
#define XB_TMO      128
#define XB_XCNT(j)  (256  + 64 * (j))
#define XB_XSUB(j)  (1280 + 64 * (j))
#define XB_XGEN(j)  (2304 + 64 * (j))
#define XB_TOP      3328
#define XB_TOPGEN   3392
#define XCD_BAR_WORDS 3456
#define XB_SPIN_CAP (1u << 18)
#define LAS __attribute__((address_space(3)))

__device__ __forceinline__ unsigned xb_ld(unsigned* p)              { return __hip_atomic_load(p, __ATOMIC_RELAXED, __HIP_MEMORY_SCOPE_AGENT); }
__device__ __forceinline__ unsigned xb_add(unsigned* p, unsigned v) { return __hip_atomic_fetch_add(p, v, __ATOMIC_RELAXED, __HIP_MEMORY_SCOPE_AGENT); }
__device__ __forceinline__ unsigned xb_xcc_id() { return (unsigned)__builtin_amdgcn_s_getreg((3 << 11) | 20) & 0xFu; }
#define XB_SPIN(cond, bar) do { unsigned _sp = 0; while (cond) { __builtin_amdgcn_s_sleep(1); \
    if ((++_sp & 255u) == 0u) { if (xb_ld(&(bar)[XB_TMO])) break; if (_sp > XB_SPIN_CAP) { atomicAdd(&(bar)[XB_TMO], 1u); break; } } } } while (0)

struct XcdBarrier {
    unsigned* bar; unsigned x;
    volatile LAS unsigned* st;
};

__device__ __forceinline__ XcdBarrier xcd_barrier_post(unsigned* bar, volatile LAS unsigned* st) {
    XcdBarrier b; b.bar = bar; b.x = xb_xcc_id(); b.st = st;
    if (threadIdx.x == 0) (void)xb_add(&bar[XB_XCNT(b.x)], 1u);
    return b;
}
__device__ __forceinline__ void xcd_barrier_complete(unsigned* bar, unsigned x, unsigned& nloc, unsigned& nx) {
    const unsigned G = gridDim.x * gridDim.y * gridDim.z;
    unsigned sum, cnt, mine, sp = 0u;
    for (;;) {
        sum = 0u; cnt = 0u; mine = 0u;
#pragma unroll
        for (unsigned j = 0; j < 16; ++j) { const unsigned c = xb_ld(&bar[XB_XCNT(j)]); sum += c; cnt += (c > 0u) ? 1u : 0u; mine = (j == x) ? c : mine; }
        if (sum == G) break;
        __builtin_amdgcn_s_sleep(1);
        if ((++sp & 255u) == 0u) { if (xb_ld(&bar[XB_TMO])) break; if (sp > XB_SPIN_CAP) { atomicAdd(&bar[XB_TMO], 1u); break; } }
    }
    nloc = mine > 0u ? mine : 1u; nx = cnt > 0u ? cnt : 1u;
}

__device__ __forceinline__ void xcd_barrier(const XcdBarrier& b) {
    asm volatile("s_waitcnt vmcnt(0)" ::: "memory");
    __syncthreads();
    if (threadIdx.x == 0) {
        unsigned* bar = b.bar;
        __builtin_amdgcn_s_waitcnt(0);
        unsigned nloc = b.st[0], nx = b.st[1];
        if (nloc == 0u) { xcd_barrier_complete(bar, b.x, nloc, nx); b.st[0] = nloc; b.st[1] = nx; }
        const unsigned old = xb_add(&bar[XB_XSUB(b.x)], 1u);
        const unsigned gen = old / nloc;
        if (old + 1u == (gen + 1u) * nloc) {
            __builtin_amdgcn_fence(__ATOMIC_RELEASE, "agent");
            asm volatile("s_waitcnt vmcnt(0)" ::: "memory");
            const unsigned og = xb_add(&bar[XB_TOP], 1u);
            const unsigned tg = og / nx;
            if (og + 1u == (tg + 1u) * nx) xb_add(&bar[XB_TOPGEN], 1u);
            else XB_SPIN(xb_ld(&bar[XB_TOPGEN]) == tg, bar);
            __builtin_amdgcn_fence(__ATOMIC_ACQUIRE, "agent");
            xb_add(&bar[XB_XGEN(b.x)], 1u);
            asm volatile("s_waitcnt vmcnt(0)" ::: "memory");
        } else {
            XB_SPIN(xb_ld(&bar[XB_XGEN(b.x)]) == gen, bar);
            __builtin_amdgcn_fence(__ATOMIC_ACQUIRE, "agent");
            asm volatile("s_waitcnt vmcnt(0)" ::: "memory");
        }
    }
    __syncthreads();
}
namespace pg8 {
#define PG8_LAS __attribute__((address_space(3)))
typedef unsigned short bf16_t;
typedef short bf16x8 __attribute__((ext_vector_type(8)));
typedef float f32x4 __attribute__((ext_vector_type(4)));
typedef unsigned u32x4 __attribute__((ext_vector_type(4)));
constexpr int BM = 256, BK = 64, HALF = 128, HTB = HALF * BK * 2  , STAGE_BYTES = 8 * HTB, NXCD = 8, WGM = 8;

__host__ __device__ __forceinline__ int lds_byte(int r, int c) { const int st = (r >> 4) * 2 + (c >> 5), rr = r & 15, cc = c & 31, ob = rr * 64 + cc * 2; return st * 1024 + (ob ^ (((ob >> 9) & 1) << 5)); }
__host__ __device__ __forceinline__ void stage_rc(int b, int& R, int& C) { const int st = b / 1024, sb = b % 1024, swz = sb ^ (((sb >> 9) & 1) << 5); R = (st >> 1) * 16 + swz / 64; C = (st & 1) * 32 + (swz % 64) / 2; }
__host__ __device__ __forceinline__ int perm32(int rho) { const int n = rho >> 4, i = rho & 15; return 8 * (i >> 2) + 4 * n + (i & 3); }

struct Unit { int pm, pn, koff; };
struct Gemm { const bf16_t* A; const bf16_t* Bt; int M, N, K, ld; };

struct StaticOrder {
    int nM, nN, nwg, G, c, rounds;
    __host__ __device__ void init(int M, int N, int G_, int c_) { nM = M / BM; nN = N / BM; nwg = nM * nN; G = G_; c = c_; rounds = 1 << 30; }
    __host__ __device__ static void tile_of(int L, int nwg, int nM, int nN, Unit& u) {
        int wgid = L; { const int q = nwg / NXCD, r = nwg % NXCD, xcd = wgid % NXCD, off = wgid / NXCD; wgid = (xcd < r ? xcd * (q + 1) : r * (q + 1) + (xcd - r) * q) + off; }
        const int nig = WGM * nN, gid = wgid / nig, fm = gid * WGM, gsz = (nM - fm) < WGM ? (nM - fm) : WGM;
        u.pm = fm + ((wgid % nig) % gsz); u.pn = (wgid % nig) / gsz; u.koff = 0;
    }
    __host__ __device__ bool next(int i, Unit& u) const {
        const long L = (long)i * G + c; if (L >= nwg || i >= rounds) return false;
        tile_of((int)L, nwg, nM, nN, u); return true;
    }
    __device__ __forceinline__ void a_ready(const Unit&) const {}
    __device__ __forceinline__ void done(const Unit&) const {}
};
struct TailOrder {
    int nM, nN, nwg, G, c, L0, S, kslice;
    __host__ __device__ void init(int M, int N, int G_, int c_, int S_, int kslice_) { nM = M / BM; nN = N / BM; nwg = nM * nN; G = G_; c = c_; L0 = (nwg / G_) * G_; S = S_; kslice = kslice_; }
    __host__ __device__ bool next(int i, Unit& u) const {
        const long j = (long)i * G + c; if (j >= (long)(nwg - L0) * S) return false;
        StaticOrder::tile_of(L0 + (int)(j / S), nwg, nM, nN, u); u.koff = (int)(j % S) * kslice; return true;
    }
    __device__ __forceinline__ void a_ready(const Unit&) const {}
    __device__ __forceinline__ void done(const Unit&) const {}
};
__device__ __forceinline__ unsigned cvt_pk_bf16(float lo, float hi) { unsigned r; asm volatile("v_cvt_pk_bf16_f32 %0, %1, %2" : "=v"(r) : "v"(lo), "v"(hi)); return r; }
template <class Epi, class Sched, bool STAMP = false>
__device__ __forceinline__ void gemm_phase(PG8_LAS unsigned char* lds, const Gemm g, const Sched& S, const Epi& E, unsigned long long* stamps) {
    int tid_ = threadIdx.x; asm volatile("" : "+v"(tid_));
    const int tid = tid_, wid = __builtin_amdgcn_readfirstlane(tid >> 6), lane = tid & 63, wr = wid >> 2, wc = wid & 3, fr = lane & 15, fq = lane >> 4;
    const int K = g.ld, nt = g.K / BK;
    unsigned voffA[2], voffB[2];
#pragma unroll
    for (int i = 0; i < 2; ++i) { int R, C; stage_rc(tid * 16 + i * 8192, R, C); const int Rb = Epi::PERM ? ((R & ~31) + perm32(R & 31)) : R;
        voffA[i] = (unsigned)(R * K + C) * 2u; voffB[i] = (unsigned)(Rb * K + C) * 2u; }
    const size_t kstep = (size_t)(BK * 2);
    const size_t hstep = (size_t)HALF * K * 2;
    const size_t tstep = 2 * hstep;
    const unsigned ldsw = (unsigned)wid * 1024u;
    const int aoff = lds_byte(wr * 64 + fr, fq * 8), boff = lds_byte(wc * 32 + fr, fq * 8);
#define PG8_SA(b, h) (((b) * 2 + (h)) * HTB)
#define PG8_SB(b, h) ((4 + (b) * 2 + (h)) * HTB)
#define PG8_STAGE(bufoff, gbase, voff) do { _Pragma("unroll") for (int _i = 0; _i < 2; ++_i) \
        __builtin_amdgcn_global_load_lds((const unsigned*)((const char*)(gbase) + (voff)[_i]), (PG8_LAS unsigned*)(lds + (bufoff) + ldsw + _i * 8192), 16, 0, 0); } while (0)
#define PG8_LDA(dst, b, h) do { _Pragma("unroll") for (int m = 0; m < 4; ++m) _Pragma("unroll") for (int k = 0; k < 2; ++k) dst[m][k] = *(const PG8_LAS bf16x8*)(lds + PG8_SA(b, h) + aoff + m * 2048 + k * 1024); } while (0)
#define PG8_LDB(dst, b, h) do { _Pragma("unroll") for (int n = 0; n < 2; ++n) _Pragma("unroll") for (int k = 0; k < 2; ++k) dst[n][k] = *(const PG8_LAS bf16x8*)(lds + PG8_SB(b, h) + boff + n * 2048 + k * 1024); } while (0)
#define PG8_MMA(ai, bj, At, Bt) do { __builtin_amdgcn_s_setprio(1); _Pragma("unroll") for (int m = 0; m < 4; ++m) _Pragma("unroll") for (int n = 0; n < 2; ++n) _Pragma("unroll") for (int k = 0; k < 2; ++k) \
        acc[ai][bj][m][n] = __builtin_amdgcn_mfma_f32_16x16x32_bf16(Bt[n][k], At[m][k], acc[ai][bj][m][n], 0, 0, 0); __builtin_amdgcn_s_setprio(0); } while (0)
#define PG8_WAIT_V(n) asm volatile("s_waitcnt vmcnt(" #n ")" ::: "memory")
#define PG8_WAIT_L(n) asm volatile("s_waitcnt lgkmcnt(" #n ")" ::: "memory")
#define PG8_BAR __builtin_amdgcn_s_barrier()
#define PG8_SCHED __builtin_amdgcn_sched_barrier(0)
    Unit cur, nxt; int ui = 0;
    if (!S.next(0, cur)) return;
    f32x4 acc[2][2][4][2];
#pragma unroll
    for (int a = 0; a < 2; ++a)
#pragma unroll
        for (int b = 0; b < 2; ++b)
#pragma unroll
            for (int m = 0; m < 4; ++m)
#pragma unroll
                for (int n = 0; n < 2; ++n) acc[a][b][m][n] = (f32x4){0.f, 0.f, 0.f, 0.f};
    bf16x8 At[4][2], B0[2][2], B1[2][2];
    const char* cA = (const char*)g.A + (size_t)cur.pm * tstep + (size_t)cur.koff * 2; const char* cB = (const char*)g.Bt + (size_t)cur.pn * tstep + (size_t)cur.koff * 2;
    S.a_ready(cur);
    PG8_STAGE(PG8_SB(0, 0), cB, voffB); PG8_STAGE(PG8_SA(0, 0), cA, voffA); PG8_STAGE(PG8_SB(0, 1), cB + hstep, voffB); PG8_STAGE(PG8_SA(0, 1), cA + hstep, voffA);
    if (wr == 1) PG8_BAR;
    PG8_WAIT_V(4); PG8_BAR;
    PG8_STAGE(PG8_SB(1, 0), cB + kstep, voffB); PG8_STAGE(PG8_SA(1, 0), cA + kstep, voffA); PG8_STAGE(PG8_SB(1, 1), cB + hstep + kstep, voffB);
    PG8_WAIT_V(6); PG8_BAR;
    for (;;) {
        const bool has_next = S.next(ui + 1, nxt);
        const char* nA = has_next ? (const char*)g.A + (size_t)nxt.pm * tstep + (size_t)nxt.koff * 2 : cA; const char* nB = has_next ? (const char*)g.Bt + (size_t)nxt.pn * tstep + (size_t)nxt.koff * 2 : cB;
        for (int t = 0; t < nt; t += 2) {
            const bool last = (t == nt - 2);
            const char* a1 = cA + (size_t)(t + 1) * kstep;
            const char* a2 = last ? nA : cA + (size_t)(t + 2) * kstep; const char* b2 = last ? nB : cB + (size_t)(t + 2) * kstep;
            const char* a3 = a2 + kstep; const char* b3 = b2 + kstep;
            if (last && has_next) S.a_ready(nxt);
            PG8_LDB(B0, 0, 0); PG8_SCHED; PG8_LDA(At, 0, 0); PG8_STAGE(PG8_SA(1, 1), a1 + hstep, voffA);
            PG8_WAIT_L(8); PG8_BAR; PG8_WAIT_L(0); PG8_MMA(0, 0, At, B0); PG8_BAR; PG8_SCHED;
            PG8_LDB(B1, 0, 1); PG8_STAGE(PG8_SB(0, 0), b2, voffB);
            PG8_BAR; PG8_WAIT_L(0); PG8_MMA(0, 1, At, B1); PG8_BAR;
            PG8_LDA(At, 0, 1); PG8_STAGE(PG8_SA(0, 0), a2, voffA);
            PG8_BAR; PG8_WAIT_L(0); PG8_MMA(1, 0, At, B0); PG8_BAR; PG8_SCHED;
            PG8_STAGE(PG8_SB(0, 1), b2 + hstep, voffB);
            PG8_WAIT_V(6); PG8_BAR; PG8_MMA(1, 1, At, B1); PG8_BAR;
            PG8_LDB(B0, 1, 0); PG8_SCHED; PG8_LDA(At, 1, 0); PG8_STAGE(PG8_SA(0, 1), a2 + hstep, voffA);
            PG8_WAIT_L(8); PG8_BAR; PG8_WAIT_L(0); PG8_MMA(0, 0, At, B0); PG8_BAR; PG8_SCHED;
            PG8_LDB(B1, 1, 1); PG8_STAGE(PG8_SB(1, 0), b3, voffB);
            PG8_BAR; PG8_WAIT_L(0); PG8_MMA(0, 1, At, B1); PG8_BAR;
            PG8_LDA(At, 1, 1); PG8_STAGE(PG8_SA(1, 0), a3, voffA);
            PG8_BAR; PG8_WAIT_L(0); PG8_MMA(1, 0, At, B0); PG8_BAR; PG8_SCHED;
            PG8_STAGE(PG8_SB(1, 1), b3 + hstep, voffB);
            PG8_WAIT_V(6); PG8_BAR; PG8_MMA(1, 1, At, B1); PG8_BAR;
        }
        if constexpr (!Epi::AFTER_DRAIN) { E(acc, cur, wr, wc, fr, fq); S.done(cur); }
        if (!has_next) break;
#pragma unroll
        for (int a = 0; a < 2; ++a)
#pragma unroll
            for (int b = 0; b < 2; ++b)
#pragma unroll
                for (int m = 0; m < 4; ++m)
#pragma unroll
                    for (int n = 0; n < 2; ++n) acc[a][b][m][n] = (f32x4){0.f, 0.f, 0.f, 0.f};
        cur = nxt; cA = nA; cB = nB; ++ui;
    }
    PG8_WAIT_V(0);
    if (wr == 0) PG8_BAR;
    PG8_BAR;
    if constexpr (Epi::AFTER_DRAIN) { E.fused(acc, cur, wr, wc, fr, fq, lds, wid, lane); S.done(cur); }
#undef PG8_SA
#undef PG8_SB
#undef PG8_STAGE
#undef PG8_LDA
#undef PG8_LDB
#undef PG8_MMA
#undef PG8_WAIT_V
#undef PG8_WAIT_L
#undef PG8_BAR
#undef PG8_SCHED
}
}
#ifndef CFG_B
#define CFG_B 4
#define CFG_T 2048
#define CFG_TC 256
#define CFG_D 2048
#define CFG_FF 5632
#define CFG_L 4
#endif
constexpr int B_ = CFG_B, T_ = CFG_T, TC_ = CFG_TC, D_ = CFG_D, FF_ = CFG_FF, L_ = CFG_L;
constexpr int NV = B_ + 1;
constexpr int MX = B_ * T_, MCX = B_ * TC_, MT = MX + MCX;
constexpr int NCH = MT / 64, XCH = T_ / 64, CCH = TC_ / 64, NSC = XCH + CCH;
constexpr int GW = 64, ROWS = T_ / GW;
constexpr int DIN = 7696, NP = 7680, NPAD = 7936, DMIX = 2048, D6 = 6 * D_, FF2 = 2 * FF_;
constexpr int NSW = 128 + TC_;
constexpr int KPARTS = 32;
constexpr float EPS_ = 1e-6f;
constexpr int A_Q = 0, A_I = 512, A_ZF = 1024, A_G = 2048;
constexpr int B_Q = 2560, B_V = 3584;
constexpr int C_Q = 4096, C_K = 4608, C_V = 5120;
constexpr int D_Q = 5632, D_K = 6144, D_V = 6656, D_O = 7168;

typedef unsigned short bf16_t;
DEV float bf2f(bf16_t b) { unsigned u = ((unsigned)b) << 16; float f; __builtin_memcpy(&f, &u, 4); return f; }
DEV bf16_t f2bf(float f) { unsigned u; __builtin_memcpy(&u, &f, 4); u += 0x7FFFu + ((u >> 16) & 1u); return (bf16_t)(u >> 16); }
DEV float sigmoidf_(float x) { return 1.0f / (1.0f + expf(-x)); }
DEV float siluf_(float x) { return x / (1.0f + expf(-x)); }
DEV float logsigf_(float x) { return x >= 0.f ? -log1pf(expf(-x)) : x - log1pf(expf(x)); }
DEV int imin(int a, int b) { return a < b ? a : b; }
DEV int imax(int a, int b) { return a > b ? a : b; }
DEV int iclip(int v, int lo, int hi) { return v < lo ? lo : (v > hi ? hi : v); }

#ifdef HOST_TEST
#define WS_FIELDS_HOST(F) \
    F(PART, float, (size_t)MT * (D_ / 64)) \
    F(RSTD, float, MT) \
    F(HA, float, (size_t)2 * NCH * 4 * 4096) \
    F(MQK, float, (size_t)NCH * 4 * 4096) \
    F(MW, float, (size_t)2 * NCH * 4 * 4096) \
    F(MSC, float, (size_t)2 * MT * 4 * 2) \
    F(DO, float, (size_t)2 * MT * 512) \
    F(NS, float, (size_t)MT * 4 * NSW)
#else
#define WS_FIELDS_HOST(F) \
    F(PART, float, 0) \
    F(RSTD, float, 0) \
    F(HA, float, 0) \
    F(MQK, float, 0) \
    F(MW, float, 0) \
    F(MSC, float, 0) \
    F(DO, float, 0) \
    F(NS, float, 0)
#endif
#define WS_FIELDS(F) \
    F(ctl, unsigned, (size_t)1 << 16) \
    WS_FIELDS_HOST(F) \
    F(PARTS, float, (size_t)8 * MCX * D_) \
    F(ROPE, float, 64 * 16 * 2) \
    F(HSB, bf16_t, (size_t)2 * NCH * 4 * 16384) \
    F(MSB, bf16_t, (size_t)2 * NCH * 4 * 16384) \
    F(X, float, (size_t)MT * D_) \
    F(XB, bf16_t, (size_t)MT * D_) \
    F(SC, float, NV * D_) \
    F(MODP, float, (size_t)L_ * KPARTS * NV * D6) \
    F(MOD, float, (size_t)L_ * NV * D6) \
    F(LBV, float, L_ * 2 * 512) \
    F(LAMF, float, 64) \
    F(G, float, (size_t)MT * 16) \
    F(Hb, bf16_t, (size_t)MT * D_) \
    F(Pb, bf16_t, (size_t)MT * NP) \
    F(QKB, bf16_t, (size_t)MT * 1024) \
    F(Y, bf16_t, (size_t)MT * DMIX) \
    F(U, bf16_t, (size_t)MT * FF2) \
    F(ACT, bf16_t, (size_t)MT * FF_) \
    F(QH, float, (size_t)MT * 512) \
    F(KK, float, (size_t)2 * MT * 512) \
    F(BC, float, (size_t)2 * MT * 512) \
    F(BL, float, (size_t)2 * NCH * 512) \
    F(HST, float, (size_t)2 * NCH * 4 * 16384) \
    F(HO, float, (size_t)2 * MT * 512) \
    F(MB, float, (size_t)2 * MT * 4) \
    F(MWU, float, (size_t)2 * MT * 4) \
    F(MLI, float, (size_t)2 * MT * 4) \
    F(MBL, float, (size_t)2 * NCH * 4) \
    F(MML, float, (size_t)2 * NCH * 4) \
    F(MMIN, float, (size_t)2 * NCH * 4) \
    F(MCs, float, (size_t)2 * NCH * 4 * 16384) \
    F(MN, float, (size_t)2 * NCH * 4 * 128) \
    F(MH, float, (size_t)2 * MT * 512) \
    F(Wt_in, bf16_t, (size_t)L_ * NPAD * D_) \
    F(Wt_out, bf16_t, (size_t)L_ * D_ * DMIX) \
    F(Wt_up, bf16_t, (size_t)L_ * FF2 * D_) \
    F(Wt_down, bf16_t, (size_t)L_ * D_ * FF_)
enum WsId {
#define F(name, type, count) W_##name,
    WS_FIELDS(F)
#undef F
    W_COUNT };
constexpr size_t WS_BYTES[W_COUNT] = {
#define F(name, type, count) (size_t)(count) * sizeof(type),
    WS_FIELDS(F)
#undef F
};
constexpr size_t ws_off(int id) { size_t o = 0; for (int i = 0; i < id; ++i) o += (WS_BYTES[i] + 255) & ~(size_t)255; return o; }
constexpr size_t WS_TOTAL = ws_off(W_COUNT);
struct Ctx {
#ifdef HOST_TEST
    const float* in_[20]; float* out_;
    MDEV const float* inp(int i) const { return in_[i]; }
    MDEV float* out() const { return out_; }
#else
    MDEV const float* inp(int i) const { return ((const float* const __attribute__((address_space(4)))*)__builtin_amdgcn_kernarg_segment_ptr())[i]; }
    MDEV float* out() const { return (float*)inp(20); }
#endif
    MDEV const float* x_in() const { return inp(0); }
    MDEV const float* c_in() const { return inp(1); }
    MDEV const float* ctx_in() const { return inp(2); }
    MDEV const float* c_ctx() const { return inp(3); }
    MDEV const float* w_ada() const { return inp(4); }
    MDEV const float* b_ada() const { return inp(5); }
    MDEV const float* w_in() const { return inp(6); }
    MDEV const float* hgrn_lb() const { return inp(7); }
    MDEV const float* hgrn_norm_w() const { return inp(8); }
    MDEV const float* diff_lam() const { return inp(9); }
    MDEV const float* diff_norm_w() const { return inp(10); }
    MDEV const float* na_rpb() const { return inp(11); }
    MDEV const float* mlstm_f_bias() const { return inp(12); }
    MDEV const float* mlstm_norm_w() const { return inp(13); }
    MDEV const float* w_out() const { return inp(14); }
    MDEV const float* w_up() const { return inp(15); }
    MDEV const float* conv_w() const { return inp(16); }
    MDEV const float* conv_b() const { return inp(17); }
    MDEV const float* w_down() const { return inp(18); }
    MDEV const float* final_norm_w() const { return inp(19); }
    unsigned char* ws;
#define F(name, type, count) MDEV type* name() const { constexpr size_t o = ws_off(W_##name); return (type*)(ws + o); }
    WS_FIELDS(F)
#undef F
};

DEV int row_vec(int m) { return m < MX ? m / T_ : B_; }
DEV int row_batch(int m) { return m < MX ? m / T_ : (m - MX) / TC_; }
DEV int row_pos(int m) { return m < MX ? m % T_ : (m - MX) % TC_; }
DEV int row_len(int m) { return m < MX ? T_ : TC_; }
DEV int stream_chunk(int dir, int b, int i) {
    if (i < CCH) { const int cc = dir == 0 ? i : CCH - 1 - i; return (MX + b * TC_) / 64 + cc; }
    const int j = i - CCH, xc = dir == 0 ? j : XCH - 1 - j; return b * XCH + xc;
}
DEV int proc_row(int dir, int chunk, int j) { return chunk * 64 + (dir == 0 ? j : 63 - j); }
DEV int proc_idx(int dir, int m) { const int o = m & 63; return dir == 0 ? o : 63 - o; }

#ifdef HOST_TEST
constexpr long N_P0 = (long)MT * D_ + NV * D_ + L_ * 2 * 512 + L_ + 64 * 16;
#else
constexpr long N_P0 = NV * D_ + L_ * 2 * 512 + L_ + 64 * 16;
#endif
DEV void st_prologue(const Ctx& c, long i) {
#ifdef HOST_TEST
    if (i < (long)MT * D_) { c.X()[i] = i < (long)MX * D_ ? c.x_in()[i] : c.ctx_in()[i - (long)MX * D_]; return; }
    i -= (long)MT * D_;
#endif
    if (i < NV * D_) { const int v = (int)(i / D_), k = (int)(i % D_); c.SC()[i] = siluf_(v < B_ ? c.c_in()[v * D_ + k] : c.c_ctx()[k]); return; }
    i -= NV * D_;
    if (i < L_ * 2 * 512) {
        const int l = (int)(i / 1024), rc = (int)(i % 1024);
        float mx = -1e30f; for (int j = 0; j < L_; ++j) mx = fmaxf(mx, c.hgrn_lb()[j * 1024 + rc]);
        float den = 0.f, num = 0.f; for (int j = 0; j < L_; ++j) { const float e = expf(c.hgrn_lb()[j * 1024 + rc] - mx); den += e; if (j >= 1 && j <= l) num += e; }
        c.LBV()[i] = num / den; return; }
    i -= L_ * 2 * 512;
    if (i >= L_) { const int k = (int)(i - L_), pos = k >> 4, ii = k & 15; const float ang = (float)pos * powf(10000.0f, -(float)(2 * ii) / 32.0f); c.ROPE()[2 * k] = cosf(ang); c.ROPE()[2 * k + 1] = sinf(ang); return; }
    { const int l = (int)i; const float* lm = c.diff_lam() + l * 4 * 64; float s1 = 0.f, s2 = 0.f;
      for (int d = 0; d < 64; ++d) { s1 += lm[d] * lm[64 + d]; s2 += lm[128 + d] * lm[192 + d]; }
      const float li = 0.8f - 0.6f * expf(-0.3f * (float)l);
      c.LAMF()[2 * l] = expf(s1) - expf(s2) + li; c.LAMF()[2 * l + 1] = li; }
}
constexpr long N_MODP = (long)L_ * KPARTS * D6;
DEV void st_modp(const Ctx& c, long i) {
    const int col = (int)(i % D6), kp = (int)((i / D6) % KPARTS), l = (int)(i / ((long)D6 * KPARTS));
    float acc[NV];
#pragma unroll
    for (int v = 0; v < NV; ++v) acc[v] = 0.f;
    const int k0 = kp * (D_ / KPARTS);
    for (int k = k0; k < k0 + D_ / KPARTS; ++k) { const float w = c.w_ada()[((size_t)l * D_ + k) * D6 + col];
#pragma unroll
        for (int v = 0; v < NV; ++v) acc[v] += c.SC()[v * D_ + k] * w; }
#pragma unroll
    for (int v = 0; v < NV; ++v) c.MODP()[(((size_t)l * KPARTS + kp) * NV + v) * D6 + col] = acc[v];
}
constexpr long N_MODR = (long)L_ * NV * D6;
DEV void st_modr(const Ctx& c, long i) {
    const int col = (int)(i % D6), v = (int)((i / D6) % NV), l = (int)(i / ((long)D6 * NV));
    float s = c.b_ada()[(size_t)l * D6 + col];
    for (int kp = 0; kp < KPARTS; ++kp) s += c.MODP()[(((size_t)l * KPARTS + kp) * NV + v) * D6 + col];
    c.MOD()[i] = s;
}

constexpr long N_SS = (long)MT * (D_ / 64);
DEV void st_sumsq(const Ctx& c, long i) { const float* p = c.X() + i * 64; float s = 0.f; for (int k = 0; k < 64; ++k) s += p[k] * p[k]; c.PART()[i] = s; }
DEV void st_rstd(const Ctx& c, long m) { float s = 0.f; for (int k = 0; k < D_ / 64; ++k) s += c.PART()[m * (D_ / 64) + k]; c.RSTD()[m] = 1.0f / sqrtf(s / (float)D_ + EPS_); }
DEV void st_mod(const Ctx& c, int l, int which, long i) {
    const int m = (int)(i / D_), col = (int)(i % D_); const float* md = c.MOD() + ((size_t)l * NV + row_vec(m)) * D6 + which * 3 * D_;
    c.Hb()[i] = f2bf(c.X()[i] * c.RSTD()[m] * (1.0f + md[D_ + col]) + md[col]);
}

DEV void st_a1(const Ctx& c, int l, long i) {
    const int m = (int)(i / 512), col = (int)(i % 512); const bf16_t* p = c.Pb() + (size_t)m * NP;
    c.QH()[i] = siluf_(bf2f(p[A_Q + col])) * 0.08838834764831845f;
    for (int dir = 0; dir < 2; ++dir) { const float z = bf2f(p[A_ZF + dir * 512 + col]), lb = c.LBV()[(l * 2 + dir) * 512 + col];
        const float kk = (1.0f - lb) * sigmoidf_(-z);
        c.KK()[((size_t)dir * MT + m) * 512 + col] = kk; c.BC()[((size_t)dir * MT + m) * 512 + col] = log1pf(-kk); }
}
DEV void st_a2(const Ctx& c, long i) {
    const int col = (int)(i % 512), chunk = (int)((i / 512) % NCH), dir = (int)(i / (512L * NCH)); float s = 0.f;
    for (int j = 0; j < 64; ++j) { float* p = c.BC() + ((size_t)dir * MT + proc_row(dir, chunk, j)) * 512 + col; s += *p; *p = s; }
    c.BL()[((size_t)dir * NCH + chunk) * 512 + col] = s;
}
DEV void st_a3(const Ctx& c, long i) {
    const int e = (int)(i & 127), d = (int)((i >> 7) & 127), h = (int)((i >> 14) & 3), chunk = (int)((i >> 16) % NCH), dir = (int)((i >> 16) / NCH);
    const float bl = c.BL()[((size_t)dir * NCH + chunk) * 512 + h * 128 + d]; float s = 0.f;
    for (int j = 0; j < 64; ++j) { const int m = chunk * 64 + j; const size_t o = ((size_t)dir * MT + m) * 512 + h * 128 + d;
        s += c.KK()[o] * expf(bl - c.BC()[o]) * bf2f(c.Pb()[(size_t)m * NP + A_I + h * 128 + e]); }
    c.HST()[i] = s;
}
DEV void st_a4(const Ctx& c, long i) {
    const int e = (int)(i & 127), d = (int)((i >> 7) & 127), h = (int)((i >> 14) & 3), b = (int)((i >> 16) % B_), dir = (int)((i >> 16) / B_);
    float S = 0.f;
    for (int s = 0; s < NSC; ++s) { const int chunk = stream_chunk(dir, b, s); float* p = c.HST() + (((size_t)dir * NCH + chunk) * 4 + h) * 16384 + d * 128 + e;
        const float t = *p; *p = S; S = expf(c.BL()[((size_t)dir * NCH + chunk) * 512 + h * 128 + d]) * S + t; }
}
DEV void st_a5(const Ctx& c, long i) {
    const int s = (int)(i & 63), t = (int)((i >> 6) & 63), h = (int)((i >> 12) & 3), chunk = (int)((i >> 14) % NCH), dir = (int)((i >> 14) / NCH);
    float a = 0.f;
    if (s <= t) { const size_t ot = ((size_t)dir * MT + proc_row(dir, chunk, t)) * 512 + h * 128, os = ((size_t)dir * MT + proc_row(dir, chunk, s)) * 512 + h * 128;
        const float* q = c.QH() + (size_t)proc_row(dir, chunk, t) * 512 + h * 128;
        for (int d = 0; d < 128; ++d) a += q[d] * c.KK()[os + d] * expf(c.BC()[ot + d] - c.BC()[os + d]); }
    c.HA()[i] = a;
}
DEV void st_a6(const Ctx& c, long i) {
    const int col = (int)(i % 512), m = (int)((i / 512) % MT), dir = (int)(i / (512L * MT)), h = col >> 7, e = col & 127, chunk = m >> 6, t = proc_idx(dir, m);
    const float* S = c.HST() + (((size_t)dir * NCH + chunk) * 4 + h) * 16384; const float* q = c.QH() + (size_t)m * 512 + h * 128; const float* bc = c.BC() + ((size_t)dir * MT + m) * 512 + h * 128;
    float o = 0.f;
    for (int d = 0; d < 128; ++d) o += q[d] * expf(bc[d]) * S[d * 128 + e];
    const float* A = c.HA() + ((((size_t)dir * NCH + chunk) * 4 + h) * 64 + t) * 64;
    for (int s = 0; s <= t; ++s) o += A[s] * bf2f(c.Pb()[(size_t)proc_row(dir, chunk, s) * NP + A_I + col]);
    c.HO()[i] = o;
}
DEV void st_a7(const Ctx& c, int l, long i) {
    const int h = (int)(i & 3), m = (int)(i >> 2); const float* o0 = c.HO() + (size_t)m * 512 + h * 128; const float* o1 = o0 + (size_t)MT * 512;
    float ss = 0.f; for (int e = 0; e < 128; ++e) { const float o = o0[e] + o1[e]; ss += o * o; }
    const float r = 1.0f / sqrtf(ss / 128.f + EPS_);
    for (int e = 0; e < 128; ++e) c.Y()[(size_t)m * DMIX + h * 128 + e] = f2bf((o0[e] + o1[e]) * r * c.hgrn_norm_w()[l * 512 + h * 128 + e] * siluf_(bf2f(c.Pb()[(size_t)m * NP + A_G + h * 128 + e])));
}

DEV void st_d2(const Ctx& c, int l, long i) {
    const int h = (int)(i & 3), chunk = (int)((i >> 2) % NCH), dir = (int)((i >> 2) / NCH); const float fb = c.mlstm_f_bias()[(l * 2 + dir) * 4 + h];
    float s = 0.f;
    for (int j = 0; j < 64; ++j) { const int m = proc_row(dir, chunk, j); const float* g = c.G() + (size_t)m * 16;
        s += logsigf_(g[(2 * dir + 1) * 4 + h] + fb); c.MB()[((size_t)dir * MT + m) * 4 + h] = s; c.MLI()[((size_t)dir * MT + m) * 4 + h] = g[(2 * dir) * 4 + h]; }
    float mx = -1e30f;
    for (int j = 0; j < 64; ++j) { const size_t o = ((size_t)dir * MT + chunk * 64 + j) * 4 + h; mx = fmaxf(mx, s - c.MB()[o] + c.MLI()[o]); }
    for (int j = 0; j < 64; ++j) { const size_t o = ((size_t)dir * MT + chunk * 64 + j) * 4 + h; c.MWU()[o] = expf(s - c.MB()[o] + c.MLI()[o] - mx); }
    c.MBL()[((size_t)dir * NCH + chunk) * 4 + h] = s; c.MML()[((size_t)dir * NCH + chunk) * 4 + h] = mx;
}
DEV void st_d3(const Ctx& c, long i) {
    const int e = (int)(i & 127), d = (int)((i >> 7) & 127), h = (int)((i >> 14) & 3), chunk = (int)((i >> 16) % NCH), dir = (int)((i >> 16) / NCH);
    float s = 0.f, sn = 0.f;
    for (int j = 0; j < 64; ++j) { const int m = chunk * 64 + j; const bf16_t* p = c.Pb() + (size_t)m * NP; const float wk = c.MWU()[((size_t)dir * MT + m) * 4 + h] * bf2f(p[D_K + h * 128 + d]);
        s += wk * bf2f(p[D_V + h * 128 + e]); sn += wk; }
    c.MCs()[i] = s; if (e == 0) c.MN()[(((size_t)dir * NCH + chunk) * 4 + h) * 128 + d] = sn;
}
DEV void st_d4(const Ctx& c, long i) {
    const int e = (int)(i & 127), d = (int)((i >> 7) & 127), h = (int)((i >> 14) & 3), b = (int)((i >> 16) % B_), dir = (int)((i >> 16) / B_);
    float C = 0.f, n = 0.f, mm = 0.f;
    for (int s = 0; s < NSC; ++s) { const int chunk = stream_chunk(dir, b, s); const size_t oc = ((size_t)dir * NCH + chunk) * 4 + h;
        const float bl = c.MBL()[oc], ml = c.MML()[oc], mn = fmaxf(bl + mm, ml), ws = expf(bl + mm - mn), wl = expf(ml - mn);
        float* p = c.MCs() + oc * 16384 + d * 128 + e; const float t = *p; *p = C; C = ws * C + wl * t;
        if (e == 0) { float* pn = c.MN() + oc * 128 + d; const float tn = *pn; *pn = n; n = ws * n + wl * tn; if (d == 0) c.MMIN()[oc] = mm; }
        mm = mn; }
}
DEV void st_d5(const Ctx& c, long i) {
    const int s = (int)(i & 63), t = (int)((i >> 6) & 63), h = (int)((i >> 12) & 3), chunk = (int)(i >> 14);
    const bf16_t* q = c.Pb() + (size_t)(chunk * 64 + t) * NP + D_Q + h * 128; const bf16_t* k = c.Pb() + (size_t)(chunk * 64 + s) * NP + D_K + h * 128;
    float a = 0.f; for (int d = 0; d < 128; ++d) a += bf2f(q[d]) * bf2f(k[d]);
    c.MQK()[i] = a * 0.08838834764831845f;
}
DEV void st_d6(const Ctx& c, long i) {
    const int h = (int)(i & 3), m = (int)((i >> 2) % MT), dir = (int)((i >> 2) / MT), chunk = m >> 6, t = proc_idx(dir, m);
    const size_t oc = ((size_t)dir * NCH + chunk) * 4 + h; const float bt = c.MB()[((size_t)dir * MT + m) * 4 + h], inter = bt + c.MMIN()[oc];
    float mt = inter;
    for (int s = 0; s <= t; ++s) { const size_t o = ((size_t)dir * MT + proc_row(dir, chunk, s)) * 4 + h; mt = fmaxf(mt, bt - c.MB()[o] + c.MLI()[o]); }
    const float wi = expf(inter - mt);
    float* W = c.MW() + (oc * 64 + t) * 64; float sw = 0.f;
    for (int s = 0; s < 64; ++s) { float w = 0.f;
        if (s <= t) { const int ms = proc_row(dir, chunk, s); const size_t o = ((size_t)dir * MT + ms) * 4 + h;
            w = expf(bt - c.MB()[o] + c.MLI()[o] - mt) * c.MQK()[(((size_t)chunk * 4 + h) * 64 + (m & 63)) * 64 + (ms & 63)]; }
        W[s] = w; sw += w; }
    const bf16_t* q = c.Pb() + (size_t)m * NP + D_Q + h * 128; const float* nin = c.MN() + oc * 128; float qn = 0.f;
    for (int d = 0; d < 128; ++d) qn += bf2f(q[d]) * nin[d];
    const float den = wi * qn * 0.08838834764831845f + sw;
    c.MSC()[(((size_t)dir * MT + m) * 4 + h) * 2] = wi * 0.08838834764831845f; c.MSC()[(((size_t)dir * MT + m) * 4 + h) * 2 + 1] = 1.0f / fmaxf(fabsf(den), expf(-mt));
}
DEV void st_d7(const Ctx& c, long i) {
    const int col = (int)(i % 512), m = (int)((i / 512) % MT), dir = (int)(i / (512L * MT)), h = col >> 7, e = col & 127, chunk = m >> 6, t = proc_idx(dir, m);
    const size_t oc = ((size_t)dir * NCH + chunk) * 4 + h; const float* Cin = c.MCs() + oc * 16384; const bf16_t* q = c.Pb() + (size_t)m * NP + D_Q + h * 128;
    float a = 0.f; for (int d = 0; d < 128; ++d) a += bf2f(q[d]) * Cin[d * 128 + e];
    const float* sc = c.MSC() + (((size_t)dir * MT + m) * 4 + h) * 2; float num = sc[0] * a;
    const float* W = c.MW() + (oc * 64 + t) * 64;
    for (int s = 0; s <= t; ++s) num += W[s] * bf2f(c.Pb()[(size_t)proc_row(dir, chunk, s) * NP + D_V + col]);
    c.MH()[i] = num * sc[1];
}
DEV void st_d8(const Ctx& c, int l, long i) {
    const int h = (int)(i & 3), m = (int)(i >> 2); const float* h0 = c.MH() + (size_t)m * 512 + h * 128; const float* h1 = h0 + (size_t)MT * 512; const bf16_t* og = c.Pb() + (size_t)m * NP + D_O + h * 128;
    float ss = 0.f; for (int e = 0; e < 128; ++e) { const float v = sigmoidf_(bf2f(og[e])) * (h0[e] + h1[e]); ss += v * v; }
    const float r = 1.0f / sqrtf(ss / 128.f + EPS_);
    for (int e = 0; e < 128; ++e) c.Y()[(size_t)m * DMIX + 1536 + h * 128 + e] = f2bf(sigmoidf_(bf2f(og[e])) * (h0[e] + h1[e]) * r * c.mlstm_norm_w()[l * 512 + h * 128 + e]);
}

DEV void st_b1(const Ctx& c, long i) {
    const int pr = (int)(i & 31), blk = (int)((i >> 5) & 7), which = (int)((i >> 8) & 1), m = (int)(i >> 9);
    const int ii = pr & 15, base = which * 512 + blk * 64 + (pr < 16 ? 0 : 32) + ii; const bf16_t* p = c.Pb() + (size_t)m * NP + B_Q;
    const float va = bf2f(p[base]), vb = bf2f(p[base + 16]); float oa = va, ob = vb;
    if (m < MX) { const int t = m % T_, pos = pr < 16 ? t / GW : t % GW; const float inv = powf(10000.0f, -(float)(2 * ii) / 32.0f), ang = (float)pos * inv, cs = cosf(ang), sn = sinf(ang);
        oa = va * cs - vb * sn; ob = vb * cs + va * sn; }
    c.QKB()[(size_t)m * 1024 + base] = f2bf(oa); c.QKB()[(size_t)m * 1024 + base + 16] = f2bf(ob);
}
DEV void st_b2(const Ctx& c, int ctx_out, long i) {
    const int hf = (int)(i & 3), map = (int)((i >> 2) & 1), h = (int)((i >> 3) & 3), m = (int)(i >> 5);
    if (m >= MX && !ctx_out) return;
    const int b = row_batch(m); float q[64];
#pragma unroll
    for (int d = 0; d < 64; ++d) q[d] = bf2f(c.QKB()[(size_t)m * 1024 + h * 128 + map * 64 + d]) * 0.125f;
    const int nlat = m < MX ? T_ : 0, nk = nlat + TC_;
    float mx = -1e30f, acc[32], den = 0.f;
#pragma unroll
    for (int e = 0; e < 32; ++e) acc[e] = 0.f;
    for (int j = 0; j < nk; ++j) { const int r = j < nlat ? b * T_ + j : MX + b * TC_ + (j - nlat); const bf16_t* k = c.QKB() + (size_t)r * 1024 + 512 + h * 128 + map * 64; float s = 0.f;
#pragma unroll
        for (int d = 0; d < 64; ++d) s += q[d] * bf2f(k[d]);
        if (s > mx) { const float f = expf(mx - s); den *= f;
#pragma unroll
            for (int e = 0; e < 32; ++e) acc[e] *= f;
            mx = s; }
        const float pz = expf(s - mx); den += pz; const bf16_t* v = c.Pb() + (size_t)r * NP + B_V + h * 128 + hf * 32;
#pragma unroll
        for (int e = 0; e < 32; ++e) acc[e] += pz * bf2f(v[e]); }
    const float rd = 1.0f / den; float* o = c.DO() + ((size_t)map * MT + m) * 512 + h * 128 + hf * 32;
#pragma unroll
    for (int e = 0; e < 32; ++e) o[e] = acc[e] * rd;
}
DEV void st_b3(const Ctx& c, int l, long i) {
    const int h = (int)(i & 3), m = (int)(i >> 2); const float lamf = c.LAMF()[2 * l], li = c.LAMF()[2 * l + 1];
    const float* o0 = c.DO() + (size_t)m * 512 + h * 128; const float* o1 = o0 + (size_t)MT * 512;
    float ss = 0.f; for (int e = 0; e < 128; ++e) { const float v = o0[e] - lamf * o1[e]; ss += v * v; }
    const float r = 1.0f / sqrtf(ss / 128.f + EPS_);
    for (int e = 0; e < 128; ++e) c.Y()[(size_t)m * DMIX + 512 + h * 128 + e] = f2bf((o0[e] - lamf * o1[e]) * r * c.diff_norm_w()[l * 512 + h * 128 + e] * (1.0f - li));
}

DEV int na_key_row(int m, int j, int& roff, int& coff) {
    const int b = m / T_, t = m % T_, r = t / GW, wq = t % GW;
    if (j >= 128) { roff = -1; coff = -1; return MX + b * TC_ + (j - 128); }
    const int rs = iclip(r - 4, 0, ROWS - 8), cs = iclip(wq - 8, 0, GW - 16), kr = rs + (j >> 4), kc = cs + (j & 15);
    roff = kr - r + 7; coff = iclip(kc - wq, -15, 15) + 15; return b * T_ + kr * GW + kc;
}
DEV void st_c1(const Ctx& c, int l, long i) {
    const int j = (int)(i % NSW), h = (int)((i / NSW) & 3), m = (int)(i / (4L * NSW));
    int kr, roff = -1, coff = -1;
    if (m < MX) kr = na_key_row(m, j, roff, coff); else { if (j >= TC_) return; kr = MX + row_batch(m) * TC_ + j; }
    const bf16_t* q = c.Pb() + (size_t)m * NP + C_Q + h * 128; const bf16_t* k = c.Pb() + (size_t)kr * NP + C_K + h * 128;
    float s = 0.f; for (int d = 0; d < 128; ++d) s += bf2f(q[d]) * bf2f(k[d]);
    s *= 0.08838834764831845f;
    if (roff >= 0) s += c.na_rpb()[((l * 4 + h) * 15 + roff) * 31 + coff];
    c.NS()[i] = s;
}
DEV void st_c2(const Ctx& c, long i) {
    const int m = (int)(i >> 2); const int n = m < MX ? NSW : TC_; float* s = c.NS() + i * NSW;
    float mx = -1e30f; for (int j = 0; j < n; ++j) mx = fmaxf(mx, s[j]);
    float den = 0.f; for (int j = 0; j < n; ++j) { const float e = expf(s[j] - mx); s[j] = e; den += e; }
    const float r = 1.0f / den; for (int j = 0; j < n; ++j) s[j] *= r;
}
DEV void st_c3(const Ctx& c, long i) {
    const int col = (int)(i % 512), m = (int)(i / 512), h = col >> 7; const float* p = c.NS() + ((size_t)m * 4 + h) * NSW; float o = 0.f;
    if (m < MX) { for (int j = 0; j < NSW; ++j) { int ro, co; const int kr = na_key_row(m, j, ro, co); o += p[j] * bf2f(c.Pb()[(size_t)kr * NP + C_V + col]); } }
    else { const int b = row_batch(m); for (int j = 0; j < TC_; ++j) o += p[j] * bf2f(c.Pb()[(size_t)(MX + b * TC_ + j) * NP + C_V + col]); }
    c.Y()[(size_t)m * DMIX + 1024 + col] = f2bf(o);
}

DEV void st_conv(const Ctx& c, int l, long i) {
    const int j = (int)(i % FF_), m = (int)(i / FF_), pos = row_pos(m), len = row_len(m); float v[2];
#pragma unroll
    for (int hf = 0; hf < 2; ++hf) { const int cc = hf * FF_ + j; float s = c.conv_b()[(size_t)l * FF2 + cc];
        for (int dt = -1; dt <= 1; ++dt) if (pos + dt >= 0 && pos + dt < len) s += c.conv_w()[((size_t)l * 3 + dt + 1) * FF2 + cc] * bf2f(c.U()[(size_t)(m + dt) * FF2 + cc]);
        v[hf] = s; }
    c.ACT()[i] = f2bf(siluf_(v[0]) * v[1]);
}
DEV void st_final(const Ctx& c, long i) { const int m = (int)(i / D_), col = (int)(i % D_); c.out()[i] = c.X()[i] * c.RSTD()[m] * c.final_norm_w()[col]; }
constexpr int PH_PRO = 3, PH_LAYER = 17, PH_FIN = 3, NPH = PH_PRO + L_ * PH_LAYER + PH_FIN;
namespace fa {
typedef short bf16x8 __attribute__((ext_vector_type(8)));
typedef short s16x4 __attribute__((ext_vector_type(4)));
typedef float f32x16 __attribute__((ext_vector_type(16)));
typedef float f32x2 __attribute__((ext_vector_type(2)));
typedef __bf16 bf16x2 __attribute__((ext_vector_type(2)));
typedef unsigned u32x4 __attribute__((ext_vector_type(4)));
typedef unsigned u32x2 __attribute__((ext_vector_type(2)));
constexpr int KOFF0 = 0, VOFF0 = 32768, BUFB = 16384, XOFF = 0, RPB_OFF = 65536, RPB_PAD = 48, FA_LDS = 65536 + 4 * (15 * 31 + 2 * 48);
constexpr float LOG2E = 1.4426950408889634f;

DEV unsigned pk2(float a, float b) { const f32x2 v = {a, b}; return __builtin_bit_cast(unsigned, __builtin_convertvector(v, bf16x2)); }
DEV unsigned off_a(unsigned row, unsigned ch) { return 2048u * (row >> 3) + 512u * (ch >> 2) + 64u * (row & 7) + 16u * ((ch & 3) ^ ((row >> 2) & 3)); }
DEV int crow(int reg, int h) { return (reg & 3) + 8 * (reg >> 2) + 4 * h; }
DEV bf16x8 pack8(const f32x16& x, int s8) {
    u32x4 p; p.x = pk2(x[s8 + 0], x[s8 + 1]); p.y = pk2(x[s8 + 2], x[s8 + 3]); p.z = pk2(x[s8 + 4], x[s8 + 5]); p.w = pk2(x[s8 + 6], x[s8 + 7]); return __builtin_bit_cast(bf16x8, p);
}
DEV float max3_(float a, float b, float c) { float r; asm("v_max3_f32 %0, %1, %2, %3" : "=v"(r) : "v"(a), "v"(b), "v"(c)); return r; }
DEV float max2_(float a, float b) { float r; asm("v_max_f32 %0, %1, %2" : "=v"(r) : "v"(a), "v"(b)); return r; }
DEV float xhalf_sum(float v) { const auto rr = __builtin_amdgcn_permlane32_swap(__builtin_bit_cast(unsigned, v), __builtin_bit_cast(unsigned, v), false, false); return __builtin_bit_cast(float, (unsigned)rr[0]) + __builtin_bit_cast(float, (unsigned)rr[1]); }
DEV float xhalf_max(float v) { const auto rr = __builtin_amdgcn_permlane32_swap(__builtin_bit_cast(unsigned, v), __builtin_bit_cast(unsigned, v), false, false); return max2_(__builtin_bit_cast(float, (unsigned)rr[0]), __builtin_bit_cast(float, (unsigned)rr[1])); }
template <int K> DEV float swz_xor(float v) { return __builtin_bit_cast(float, __builtin_amdgcn_ds_swizzle(__builtin_bit_cast(int, v), (K << 10) | 0x1f)); }
DEV float bperm(float v, int src_lane) { return __builtin_bit_cast(float, __builtin_amdgcn_ds_bpermute(src_lane << 2, __builtin_bit_cast(int, v))); }
}
DEV float fexp_(float x) { return __builtin_amdgcn_exp2f(x * 1.4426950408889634f); }
DEV float flog_(float x) { return __builtin_amdgcn_logf(x) * 0.6931471805599453f; }
DEV float fsig_(float x) { return __builtin_amdgcn_rcpf(1.0f + __builtin_amdgcn_exp2f(x * -1.4426950408889634f)); }
DEV float fsilu_(float x) { return x * fsig_(x); }
namespace fa {

struct Unit {
    const bf16_t* Qp; int ldq;
    const bf16_t* Kp; int ldk;
    const bf16_t* Vp; int ldv;
    int rowA, nA, rowB, nB;
};

template <int MODE>
DEV void flash_unit(LAS unsigned char* lds, const int tid, const Unit u, int map, int band, int kr_lo, int r, int wq, f32x16 (&o)[4], float& lsum) {
    const int lane = tid & 63, r32 = lane & 31, h = lane >> 5;
    constexpr int KS = MODE == 0 ? 4 : 8;
    constexpr float C = (MODE == 0 ? 0.125f : 0.08838834764831845f) * LOG2E;
    bf16x8 qf[KS];
#pragma unroll
    for (int s = 0; s < KS; ++s) qf[s] = *(const bf16x8*)(u.Qp + (size_t)r32 * u.ldq + 16 * s + 8 * h);
    unsigned ka[2], va[2];
#pragma unroll
    for (int par = 0; par < 2; ++par) ka[par] = 2048u * (r32 >> 3) + 64u * (r32 & 7) + 16u * ((2u * par + h) ^ ((r32 >> 2) & 3)) + (MODE == 0 ? 1024u * map : 0u);
    { const unsigned q4 = (lane & 15) >> 2, p = lane & 3, blk = (lane >> 4) & 1;
#pragma unroll
      for (int t = 0; t < 2; ++t) va[t] = 2048u * t + 64u * (4u * h + q4) + 16u * ((2u * blk + (p >> 1)) ^ ((2u * t + h) & 3)) + 8u * (p & 1); }
    const int srow = tid >> 4, sch = tid & 15; const unsigned soff = off_a(srow, sch);
    const int nt = u.nA + u.nB;
    bf16x8 kstA[2], vstA[2], kstB[2], vstB[2];
#define FA_ROW0(t) ((t) < u.nA ? u.rowA + 64 * (t) : u.rowB + 64 * ((t) - u.nA))
#define FA_LOAD(S, t) do { const int row0_ = FA_ROW0(t); _Pragma("unroll") for (int i_ = 0; i_ < 2; ++i_) { \
        kst##S[i_] = *(const bf16x8*)(u.Kp + (size_t)(row0_ + srow + 32 * i_) * u.ldk + sch * 8); vst##S[i_] = *(const bf16x8*)(u.Vp + (size_t)(row0_ + srow + 32 * i_) * u.ldv + sch * 8); } } while (0)
#define FA_STORE(S, buf) do { _Pragma("unroll") for (int i_ = 0; i_ < 2; ++i_) { *(LAS bf16x8*)(lds + KOFF0 + (buf) * BUFB + soff + 8192 * i_) = kst##S[i_]; *(LAS bf16x8*)(lds + VOFF0 + (buf) * BUFB + soff + 8192 * i_) = vst##S[i_]; } } while (0)
    FA_LOAD(A, 0); FA_STORE(A, 0);
    __syncthreads();
    if (1 < nt) FA_LOAD(A, 1);
    if (2 < nt) FA_LOAD(B, 2);
#pragma unroll
    for (int c = 0; c < 4; ++c)
#pragma unroll
        for (int i = 0; i < 16; ++i) o[c][i] = 0.f;
    float m = -1e30f; lsum = 0.f;
    const int rs = MODE == 1 ? iclip(r - 4, 0, ROWS - 8) : 0, cs = MODE == 1 ? iclip(wq - 8, 0, GW - 16) : 0;
#define FA_TILE(BUF_, TT_) do { \
        bool active = true; int kr = 0; \
        if (MODE == 1 && band && (TT_) < u.nA) { kr = kr_lo + (TT_); active = kr >= rs && kr < rs + 8; } \
        if (active) { \
            f32x16 p0, p1; \
_Pragma("unroll") \
            for (int i = 0; i < 16; ++i) { p0[i] = 0.f; p1[i] = 0.f; } \
_Pragma("unroll") \
            for (int sc = 0; sc < KS; sc += 4) { bf16x8 kf0[4], kf1[4]; \
_Pragma("unroll") \
                for (int s = 0; s < 4; ++s) { kf0[s] = *(const LAS bf16x8*)(lds + KOFF0 + (BUF_) * BUFB + ka[s & 1] + 512 * ((sc + s) >> 1)); \
                    kf1[s] = *(const LAS bf16x8*)(lds + KOFF0 + (BUF_) * BUFB + ka[s & 1] + 512 * ((sc + s) >> 1) + 8192); } \
_Pragma("unroll") \
                for (int s = 0; s < 4; ++s) { p0 = __builtin_amdgcn_mfma_f32_32x32x16_bf16(kf0[s], qf[sc + s], p0, 0, 0, 0); p1 = __builtin_amdgcn_mfma_f32_32x32x16_bf16(kf1[s], qf[sc + s], p1, 0, 0, 0); } \
                __builtin_amdgcn_sched_group_barrier(0x100, 8, 0); __builtin_amdgcn_sched_group_barrier(0x008, 8, 0); \
            } \
            asm volatile("s_nop 7\n\ts_nop 7\n\ts_nop 3" : "+v"(p0), "+v"(p1));       \
            const bool bandt = MODE == 1 && band && (TT_) < u.nA; \
            if (bandt) { \
                const LAS float* rp = (const LAS float*)(lds + RPB_OFF) + RPB_PAD + (kr - r + 7) * 31 + 15 - wq + 4 * h;        \
                float bz0[16], bz1[16]; \
_Pragma("unroll") \
                for (int i = 0; i < 16; ++i) { bz0[i] = rp[crow(i, 0)]; bz1[i] = rp[crow(i, 0) + 32]; } \
_Pragma("unroll") \
                for (int i = 0; i < 16; ++i) { const int kc0 = crow(i, 0) + 4 * h, kc1 = kc0 + 32; \
                    p0[i] = (unsigned)(kc0 - cs) < 16u ? p0[i] * C + bz0[i] : -1e30f; \
                    p1[i] = (unsigned)(kc1 - cs) < 16u ? p1[i] * C + bz1[i] : -1e30f; } \
            } \
            float pm = max3_(p0[0], p1[0], p0[1]), pm2 = max3_(p1[1], p0[2], p1[2]); \
_Pragma("unroll") \
            for (int i = 3; i < 15; i += 2) { pm = max3_(pm, p0[i], p1[i]); pm2 = max3_(pm2, p0[i + 1], p1[i + 1]); } \
            pm = xhalf_max(max3_(pm, pm2, max2_(p0[15], p1[15]))); \
            if (!bandt) pm *= C; \
            const float mn = max2_(m, pm); \
            if (__builtin_amdgcn_ballot_w64(mn > m) != 0ull) { \
                const float alpha = __builtin_amdgcn_exp2f(m - mn); m = mn; lsum *= alpha; \
_Pragma("unroll") \
                for (int c = 0; c < 4; ++c) o[c] = o[c] * alpha; \
            } \
            if (bandt) { p0 = p0 - m; p1 = p1 - m; } else { p0 = p0 * C - m; p1 = p1 * C - m; } \
            float rsum = 0.f; \
_Pragma("unroll") \
            for (int i = 0; i < 16; ++i) { p0[i] = __builtin_amdgcn_exp2f(p0[i]); p1[i] = __builtin_amdgcn_exp2f(p1[i]); } \
            { const f32x16 ps = p0 + p1; \
_Pragma("unroll") \
              for (int i = 0; i < 16; ++i) rsum += ps[i]; } \
            rsum = xhalf_sum(rsum); \
            lsum += rsum; \
            const bf16x8 pb00 = pack8(p0, 0), pb01 = pack8(p0, 8), pb10 = pack8(p1, 0), pb11 = pack8(p1, 8); \
            { s16x4 vt[2][4][2];                   \
_Pragma("unroll") \
              for (int c = 0; c < 4; ++c) { const unsigned base = VOFF0 + (BUF_) * BUFB + 512 * c; \
                  vt[0][c][0] = __builtin_amdgcn_ds_read_tr16_b64_v4i16((LAS s16x4*)(lds + base + va[0])); vt[0][c][1] = __builtin_amdgcn_ds_read_tr16_b64_v4i16((LAS s16x4*)(lds + base + va[1])); } \
              __builtin_amdgcn_sched_group_barrier(0x100, 8, 0); \
_Pragma("unroll") \
              for (int g = 0; g < 4; ++g) { \
                  if (g < 3) { \
_Pragma("unroll") \
                      for (int c = 0; c < 4; ++c) { const unsigned base = VOFF0 + (BUF_) * BUFB + 8192 * ((g + 1) >> 1) + 4096 * ((g + 1) & 1) + 512 * c; \
                          vt[(g + 1) & 1][c][0] = __builtin_amdgcn_ds_read_tr16_b64_v4i16((LAS s16x4*)(lds + base + va[0])); vt[(g + 1) & 1][c][1] = __builtin_amdgcn_ds_read_tr16_b64_v4i16((LAS s16x4*)(lds + base + va[1])); } \
                      __builtin_amdgcn_sched_group_barrier(0x100, 8, 0); } \
                  const bf16x8 pb = g == 0 ? pb00 : (g == 1 ? pb01 : (g == 2 ? pb10 : pb11)); \
_Pragma("unroll") \
                  for (int c = 0; c < 4; ++c) { const s16x4 t0 = vt[g & 1][c][0], t1 = vt[g & 1][c][1]; const bf16x8 a = {t0[0], t0[1], t0[2], t0[3], t1[0], t1[1], t1[2], t1[3]}; \
                      o[c] = __builtin_amdgcn_mfma_f32_32x32x16_bf16(a, pb, o[c], 0, 0, 0); } \
                  __builtin_amdgcn_sched_group_barrier(0x008, 4, 0); } } \
        } \
    } while (0)
    for (int t = 0; t < nt; t += 2) {
        FA_TILE(0, t);
        if (t + 1 < nt) FA_STORE(A, 1);
        if (t + 3 < nt) FA_LOAD(A, t + 3);
        __syncthreads();
        if (t + 1 >= nt) break;
        FA_TILE(1, t + 1);
        if (t + 2 < nt) FA_STORE(B, 0);
        if (t + 4 < nt) FA_LOAD(B, t + 4);
        __syncthreads();
    }
#undef FA_TILE
#undef FA_ROW0
#undef FA_LOAD
#undef FA_STORE
}

DEV void diff_unit(const Ctx& c, int l, LAS unsigned char* lds, int unit) {
    int tid_ = threadIdx.x; asm volatile("" : "+v"(tid_));
    const int tid = tid_, w = __builtin_amdgcn_readfirstlane(tid >> 6), lane = tid & 63, r32 = lane & 31, h = lane >> 5, map = w & 1;
    int b, hh, qbase; Unit u;
    if (unit < B_ * 4 * (T_ / 128)) { const int qb = unit % (T_ / 128); hh = (unit / (T_ / 128)) & 3; b = unit / (4 * (T_ / 128)); qbase = b * T_ + 128 * qb;
        u.rowA = b * T_; u.nA = T_ / 64; u.rowB = MX + b * TC_; u.nB = TC_ / 64; }
    else { const int v = unit - B_ * 4 * (T_ / 128); const int qb = v % (TC_ / 128); hh = (v / (TC_ / 128)) & 3; b = v / (4 * (TC_ / 128)); qbase = MX + b * TC_ + 128 * qb;
        u.rowA = MX + b * TC_; u.nA = TC_ / 64; u.rowB = 0; u.nB = 0; }
    const int qrow0 = qbase + 32 * (w >> 1);
    u.Qp = c.QKB() + (size_t)qrow0 * 1024 + hh * 128 + map * 64; u.ldq = 1024;
    u.Kp = c.QKB() + 512 + hh * 128; u.ldk = 1024;
    u.Vp = c.Pb() + B_V + hh * 128; u.ldv = NP;
    f32x16 o[4]; float lsum;
    flash_unit<0>(lds, tid, u, map, 0, 0, 0, 0, o, lsum);
    const float inv = 1.0f / lsum;
    LAS float* xb = (LAS float*)(lds + XOFF) + (w >> 1) * 4096;
    if (map == 1) {
#pragma unroll
        for (int cc = 0; cc < 4; ++cc)
#pragma unroll
            for (int i = 0; i < 16; ++i) xb[(32 * cc + crow(i, h)) * 32 + r32] = o[cc][i] * inv;
    }
    __syncthreads();
    if (map == 0) {
        const float lamf = c.LAMF()[2 * l], li = c.LAMF()[2 * l + 1]; float ss = 0.f;
#pragma unroll
        for (int cc = 0; cc < 4; ++cc)
#pragma unroll
            for (int i = 0; i < 16; ++i) { const float d = o[cc][i] * inv - lamf * xb[(32 * cc + crow(i, h)) * 32 + r32]; o[cc][i] = d; ss += d * d; }
        ss = xhalf_sum(ss);
        const float rr = (1.0f - li) / sqrtf(ss * (1.0f / 128.f) + EPS_);
        const float* nw = c.diff_norm_w() + l * 512 + hh * 128; bf16_t* yp = c.Y() + (size_t)(qrow0 + r32) * DMIX + 512 + hh * 128;
#pragma unroll
        for (int cc = 0; cc < 4; ++cc)
#pragma unroll
            for (int g = 0; g < 4; ++g) { const int e = 32 * cc + 8 * g + 4 * h; const float4 wv = *(const float4*)(nw + e);
                u32x2 pk; pk.x = pk2(o[cc][4 * g] * rr * wv.x, o[cc][4 * g + 1] * rr * wv.y); pk.y = pk2(o[cc][4 * g + 2] * rr * wv.z, o[cc][4 * g + 3] * rr * wv.w);
                *(u32x2*)(yp + e) = pk; }
    }
    __syncthreads();
}
constexpr int N_DIFF_LAT = B_ * 4 * (T_ / 128), N_DIFF_CTX = B_ * 4 * (TC_ / 128);

DEV void na_unit(const Ctx& c, int l, LAS unsigned char* lds, int unit) {
    int tid_ = threadIdx.x; asm volatile("" : "+v"(tid_));
    const int tid = tid_, w = __builtin_amdgcn_readfirstlane(tid >> 6), lane = tid & 63, r32 = lane & 31, h = lane >> 5;
    int b, hh, qbase, band, kr_lo = 0, r = 0, wq = 0; Unit u;
    constexpr int RG = ROWS / 4;
    if (unit < B_ * 4 * RG) { const int rg = unit % RG; hh = (unit / RG) & 3; b = unit / (4 * RG); qbase = b * T_ + 256 * rg; band = 1;
        const int r0 = 4 * rg; kr_lo = iclip(r0 - 4, 0, ROWS - 8); const int kr_hi = iclip(r0 + 3 - 4, 0, ROWS - 8) + 7;
        u.rowA = b * T_ + 64 * kr_lo; u.nA = kr_hi - kr_lo + 1; u.rowB = MX + b * TC_; u.nB = TC_ / 64; r = r0 + (w >> 1); wq = 32 * (w & 1) + r32; }
    else { const int v = unit - B_ * 4 * RG; hh = v & 3; b = v >> 2; qbase = MX + b * TC_; band = 0; u.rowA = MX + b * TC_; u.nA = TC_ / 64; u.rowB = 0; u.nB = 0; }
    const int qrow0 = qbase + 32 * w;
    u.Qp = c.Pb() + (size_t)qrow0 * NP + C_Q + hh * 128; u.ldq = NP;
    u.Kp = c.Pb() + C_K + hh * 128; u.ldk = NP;
    u.Vp = c.Pb() + C_V + hh * 128; u.ldv = NP;
    if (band) { for (int i = tid; i < 15 * 31; i += 512) ((LAS float*)(lds + RPB_OFF))[RPB_PAD + i] = c.na_rpb()[(size_t)(l * 4 + hh) * 465 + i] * LOG2E; }
    f32x16 o[4]; float lsum;
    flash_unit<1>(lds, tid, u, 0, band, kr_lo, r, wq, o, lsum);
    const float inv = 1.0f / lsum; bf16_t* yp = c.Y() + (size_t)(qrow0 + r32) * DMIX + 1024 + hh * 128;
#pragma unroll
    for (int cc = 0; cc < 4; ++cc)
#pragma unroll
        for (int g = 0; g < 4; ++g) { const int e = 32 * cc + 8 * g + 4 * h;
            u32x2 pk; pk.x = pk2(o[cc][4 * g] * inv, o[cc][4 * g + 1] * inv); pk.y = pk2(o[cc][4 * g + 2] * inv, o[cc][4 * g + 3] * inv);
            *(u32x2*)(yp + e) = pk; }
    __syncthreads();
}
constexpr int N_NA_LAT = B_ * 4 * (ROWS / 4), N_NA_CTX = B_ * 4;
}
namespace ch {
using fa::bf16x8; using fa::s16x4; using fa::f32x16; using fa::u32x4; using fa::u32x2; using fa::pk2; using fa::off_a; using fa::crow; using fa::xhalf_sum;
typedef float f32x4 __attribute__((ext_vector_type(4)));
DEV bf16x8 pack8f(const f32x4 a, const f32x4 b) { u32x4 p; p.x = pk2(a[0], a[1]); p.y = pk2(a[2], a[3]); p.z = pk2(b[0], b[1]); p.w = pk2(b[2], b[3]); return __builtin_bit_cast(bf16x8, p); }
DEV float bfe(const bf16x8 v, int j) { return bf2f((bf16_t)v[j]); }
DEV unsigned nat_base(int lane, int t) { const unsigned h = lane >> 5, blk = (lane >> 4) & 1, q4 = (lane & 15) >> 2, p = lane & 3;
    return 2048u * h + 64u * (4u * t + q4) + 16u * ((2u * blk + (p >> 1)) ^ ((2u * h + t) & 3)) + 8u * (p & 1); }
DEV bf16x8 tr_frag(LAS unsigned char* lds, unsigned off, const unsigned (&nb)[2]) {
    const s16x4 t0 = __builtin_amdgcn_ds_read_tr16_b64_v4i16((LAS s16x4*)(lds + off + nb[0]));
    const s16x4 t1 = __builtin_amdgcn_ds_read_tr16_b64_v4i16((LAS s16x4*)(lds + off + nb[1]));
    return (bf16x8){t0[0], t0[1], t0[2], t0[3], t1[0], t1[1], t1[2], t1[3]};
}
DEV unsigned row_base(int lane, int par) { const unsigned r32 = lane & 31, h = lane >> 5; return 2048u * (r32 >> 3) + 64u * (r32 & 7) + 16u * ((2u * par + h) ^ ((r32 >> 2) & 3)); }

template <int MODE>
DEV void local_state_unit(const Ctx& c, LAS unsigned char* lds, const int tid, const int unit) {
    constexpr int KT = 0, VT = 16384;
    const int lane = tid & 63, w = __builtin_amdgcn_readfirstlane(tid >> 6), r32 = lane & 31, h = lane >> 5;
    const int hh = unit & 3, chunk = (unit >> 2) % NCH, dir = (unit >> 2) / NCH;
    const int srow = tid >> 4, sch = tid & 15; const unsigned soff = off_a(srow, sch);
#pragma unroll
    for (int i = 0; i < 2; ++i) { const int m = chunk * 64 + srow + 32 * i;
        const bf16x8 vv = *(const bf16x8*)(c.Pb() + (size_t)m * NP + (MODE == 0 ? A_I : D_V) + hh * 128 + sch * 8);
        bf16x8 kt;
        if (MODE == 0) { const size_t o = ((size_t)dir * MT + m) * 512 + hh * 128 + sch * 8; const float* blp = c.BL() + ((size_t)dir * NCH + chunk) * 512 + hh * 128 + sch * 8;
            const f32x4 k0 = *(const f32x4*)(c.KK() + o), k1 = *(const f32x4*)(c.KK() + o + 4), b0 = *(const f32x4*)(c.BC() + o), b1 = *(const f32x4*)(c.BC() + o + 4), l0 = *(const f32x4*)blp, l1 = *(const f32x4*)(blp + 4);
            f32x4 x0, x1;
#pragma unroll
            for (int j = 0; j < 4; ++j) { x0[j] = k0[j] * fexp_(l0[j] - b0[j]); x1[j] = k1[j] * fexp_(l1[j] - b1[j]); }
            kt = pack8f(x0, x1);
        } else { const bf16x8 kr = *(const bf16x8*)(c.Pb() + (size_t)m * NP + D_K + hh * 128 + sch * 8); const float wu = c.MWU()[((size_t)dir * MT + m) * 4 + hh];
            f32x4 x0, x1;
#pragma unroll
            for (int j = 0; j < 4; ++j) { x0[j] = wu * bfe(kr, j); x1[j] = wu * bfe(kr, 4 + j); }
            kt = pack8f(x0, x1); }
        *(LAS bf16x8*)(lds + KT + soff + 8192 * i) = kt; *(LAS bf16x8*)(lds + VT + soff + 8192 * i) = vv; }
    __syncthreads();
    unsigned nb[2]; nb[0] = nat_base(lane, 0); nb[1] = nat_base(lane, 1);
    const int dc = w >> 1, ec0 = (w & 1) * 2;
    f32x16 acc[2];
#pragma unroll
    for (int i = 0; i < 16; ++i) { acc[0][i] = 0.f; acc[1][i] = 0.f; }
#pragma unroll
    for (int sub = 0; sub < 2; ++sub)
#pragma unroll
        for (int ks = 0; ks < 2; ++ks) { const bf16x8 a = tr_frag(lds, KT + 8192 * sub + 4096 * ks + 512 * dc, nb);
#pragma unroll
            for (int e2 = 0; e2 < 2; ++e2) { const bf16x8 b = tr_frag(lds, VT + 8192 * sub + 4096 * ks + 512 * (ec0 + e2), nb); acc[e2] = __builtin_amdgcn_mfma_f32_32x32x16_bf16(a, b, acc[e2], 0, 0, 0); } }
    float* dst = (MODE == 0 ? c.HST() : c.MCs()) + (size_t)unit * 16384;
#pragma unroll
    for (int e2 = 0; e2 < 2; ++e2)
#pragma unroll
        for (int i = 0; i < 16; ++i) dst[(32 * dc + crow(i, h)) * 128 + 32 * (ec0 + e2) + r32] = acc[e2][i];
    if (MODE == 1 && tid < 128) { float sn = 0.f;
        for (int j = 0; j < 64; ++j) sn += bf2f(*(const LAS bf16_t*)(lds + KT + off_a(j & 31, tid >> 3) + 8192 * (j >> 5) + (tid & 7) * 2));
        c.MN()[(size_t)unit * 128 + tid] = sn; }
    __syncthreads();
}

DEV void mlstm_out2_unit(const Ctx& c, int l, LAS unsigned char* lds, const int tid, const int unit) {
    constexpr int QO = 0, KO = 16384, VO = 32768, SO = 49152, WO = 81920, TBL = 91136, SSQ = 94208;
    constexpr float SCALE = 0.08838834764831845f;
    const int lane = tid & 63, w = __builtin_amdgcn_readfirstlane(tid >> 6), r32 = lane & 31, h = lane >> 5;
    const int hh = unit & 3, chunk = unit >> 2, m0 = chunk * 64;
    LAS float* TB = (LAS float*)(lds + TBL); LAS float* TA = TB + 64; LAS float* TM = TB + 128; LAS float* TWI = TB + 192; LAS float* QN = TB + 256; LAS float* NIN = TB + 320;
    const int srow = tid >> 4, sch = tid & 15; const unsigned soff = off_a(srow, sch);
#pragma unroll
    for (int i = 0; i < 2; ++i) { const bf16_t* p = c.Pb() + (size_t)(m0 + srow + 32 * i) * NP + hh * 128 + sch * 8;
        *(LAS bf16x8*)(lds + QO + soff + 8192 * i) = *(const bf16x8*)(p + D_Q); *(LAS bf16x8*)(lds + KO + soff + 8192 * i) = *(const bf16x8*)(p + D_K); *(LAS bf16x8*)(lds + VO + soff + 8192 * i) = *(const bf16x8*)(p + D_V); }
    unsigned rb[2], nb[2]; rb[0] = row_base(lane, 0); rb[1] = row_base(lane, 1); nb[0] = nat_base(lane, 0); nb[1] = nat_base(lane, 1);
    const int cc = w >> 1, tb = w & 1, rt = 32 * tb + r32;
    f32x16 p, tot;
#pragma unroll
    for (int i = 0; i < 16; ++i) { p[i] = 0.f; tot[i] = 0.f; }
    for (int dir = 0; dir < 2; ++dir) {
        const int uo = (dir * NCH + chunk) * 4 + hh;
#pragma unroll
        for (int i = 0; i < 4; ++i) { const int d = srow + 32 * i; *(LAS bf16x8*)(lds + SO + soff + 8192 * i) = *(const bf16x8*)(c.MSB() + (size_t)uo * 16384 + d * 128 + sch * 8); }
        if (tid < 64) { const size_t o = ((size_t)dir * MT + m0 + tid) * 4 + hh; const float b = c.MB()[o]; TB[tid] = b; TA[tid] = c.MLI()[o] - b; }
        else if (tid < 192) NIN[tid - 64] = c.MN()[(size_t)uo * 128 + tid - 64];
        __syncthreads();
        if (tid < 64) { const int r0 = tid; const float bt = TB[r0], inter = bt + c.MMIN()[uo]; float mx = inter;
            for (int rs = 0; rs < 64; ++rs) { const bool ok = dir ? rs >= r0 : rs <= r0; if (ok) mx = fmaxf(mx, bt + TA[rs]); }
            TM[r0] = mx; TWI[r0] = fexp_(inter - mx); }
        else if (tid >= 256 && tid < 320) { const int t = tid - 256; float s = 0.f;
            for (int d = 0; d < 128; ++d) s += bf2f(*(const LAS bf16_t*)(lds + QO + off_a(t & 31, d >> 3) + 8192 * (t >> 5) + (d & 7) * 2)) * NIN[d];
            QN[t] = s * SCALE; }
        if (dir == 0 && w < 4) {
            const int st = w >> 1, tt = w & 1;
#pragma unroll
            for (int s8 = 0; s8 < 8; ++s8) { const bf16x8 a = *(const LAS bf16x8*)(lds + KO + 8192 * st + rb[s8 & 1] + 512 * (s8 >> 1)); const bf16x8 b = *(const LAS bf16x8*)(lds + QO + 8192 * tt + rb[s8 & 1] + 512 * (s8 >> 1));
                p = __builtin_amdgcn_mfma_f32_32x32x16_bf16(a, b, p, 0, 0, 0); } }
        __syncthreads();
        if (w < 4) {
            const int st = w >> 1, tt = w & 1, r0 = 32 * tt + r32; const float bt = TB[r0] - TM[r0];
#pragma unroll
            for (int g = 0; g < 4; ++g) { float wv[4];
#pragma unroll
                for (int j = 0; j < 4; ++j) { const int rs = 32 * st + 8 * g + 4 * h + j; const bool ok = dir ? rs >= r0 : rs <= r0; wv[j] = ok ? fexp_(bt + TA[rs]) * p[4 * g + j] * SCALE : 0.f; }
                u32x2 pk; pk.x = pk2(wv[0], wv[1]); pk.y = pk2(wv[2], wv[3]);
                *(LAS u32x2*)(lds + WO + r0 * 144 + (32 * st + 8 * g + 4 * h) * 2) = pk; } }
        __syncthreads();
        { f32x16 acc;
#pragma unroll
          for (int i = 0; i < 16; ++i) acc[i] = 0.f;
#pragma unroll
          for (int s8 = 0; s8 < 8; ++s8) { const bf16x8 a = tr_frag(lds, SO + 8192 * (s8 >> 1) + 4096 * (s8 & 1) + 512 * cc, nb); const bf16x8 b = *(const LAS bf16x8*)(lds + QO + 8192 * tb + rb[s8 & 1] + 512 * (s8 >> 1));
              acc = __builtin_amdgcn_mfma_f32_32x32x16_bf16(a, b, acc, 0, 0, 0); }
          const float wi = TWI[rt], ws = wi * SCALE;
#pragma unroll
          for (int i = 0; i < 16; ++i) acc[i] *= ws;
          float rsum = 0.f;
#pragma unroll
          for (int k4 = 0; k4 < 4; ++k4) { const bf16x8 b = *(const LAS bf16x8*)(lds + WO + rt * 144 + (16 * k4 + 8 * h) * 2);
#pragma unroll
              for (int j = 0; j < 8; ++j) rsum += bfe(b, j);
              const bf16x8 a = tr_frag(lds, VO + 8192 * (k4 >> 1) + 4096 * (k4 & 1) + 512 * cc, nb);
              acc = __builtin_amdgcn_mfma_f32_32x32x16_bf16(a, b, acc, 0, 0, 0); }
          rsum = xhalf_sum(rsum);
          const float den = wi * QN[rt] + rsum, rinv = 1.0f / fmaxf(fabsf(den), fexp_(-TM[rt]));
#pragma unroll
          for (int i = 0; i < 16; ++i) tot[i] += acc[i] * rinv; }
        __syncthreads();
    }
    { const bf16_t* og = c.Pb() + (size_t)(m0 + rt) * NP + D_O + hh * 128 + 32 * cc + 4 * h; float ss = 0.f;
#pragma unroll
      for (int g = 0; g < 4; ++g) { const u32x2 gv = *(const u32x2*)(og + 8 * g);
          const float g0 = bf2f((bf16_t)(gv.x & 0xffffu)), g1 = bf2f((bf16_t)(gv.x >> 16)), g2 = bf2f((bf16_t)(gv.y & 0xffffu)), g3 = bf2f((bf16_t)(gv.y >> 16));
          tot[4 * g] *= fsig_(g0); tot[4 * g + 1] *= fsig_(g1); tot[4 * g + 2] *= fsig_(g2); tot[4 * g + 3] *= fsig_(g3);
          ss += tot[4 * g] * tot[4 * g] + tot[4 * g + 1] * tot[4 * g + 1] + tot[4 * g + 2] * tot[4 * g + 2] + tot[4 * g + 3] * tot[4 * g + 3]; }
      ss = xhalf_sum(ss);
      LAS float* SQ = (LAS float*)(lds + SSQ);
      if (h == 0) SQ[rt * 4 + cc] = ss;
      __syncthreads();
      const f32x4 s4 = *(const LAS f32x4*)(SQ + rt * 4); const float r = 1.0f / sqrtf((s4[0] + s4[1] + s4[2] + s4[3]) * (1.0f / 128.f) + EPS_);
      const float* nw = c.mlstm_norm_w() + l * 512 + hh * 128 + 32 * cc + 4 * h; bf16_t* yp = c.Y() + (size_t)(m0 + rt) * DMIX + 1536 + hh * 128 + 32 * cc + 4 * h;
#pragma unroll
      for (int g = 0; g < 4; ++g) { const f32x4 wv = *(const f32x4*)(nw + 8 * g); u32x2 pk; pk.x = pk2(tot[4 * g] * r * wv[0], tot[4 * g + 1] * r * wv[1]); pk.y = pk2(tot[4 * g + 2] * r * wv[2], tot[4 * g + 3] * r * wv[3]); *(u32x2*)(yp + 8 * g) = pk; } }
    __syncthreads();
}

DEV float wmax64(float v) { v = fmaxf(v, fa::swz_xor<1>(v)); v = fmaxf(v, fa::swz_xor<2>(v)); v = fmaxf(v, fa::swz_xor<4>(v)); v = fmaxf(v, fa::swz_xor<8>(v)); v = fmaxf(v, fa::swz_xor<16>(v)); return fa::xhalf_max(v); }
DEV void mlstm_stream_unit(const Ctx& c, int l, LAS unsigned char* lds, const int tid, const int unit) {
    constexpr int QO = 0, KO = 16384, VO = 32768, KT = 49152, SO = 65536, WO = 98304, TBL = 107520;
    constexpr float SCALE = 0.08838834764831845f;
    const int lane = tid & 63, w = __builtin_amdgcn_readfirstlane(tid >> 6), r32 = lane & 31, h = lane >> 5;
    const int hh = unit & 3, b = (unit >> 2) & 3, dir = unit >> 4;
    LAS float* TB = (LAS float*)(lds + TBL); LAS float* TA = TB + 64; LAS float* TWI = TB + 128; LAS float* TEI = TB + 192; LAS float* QN = TB + 256; LAS float* NIN = TB + 320;
    const int srow = tid >> 4, sch = tid & 15; const unsigned soff = off_a(srow, sch);
    unsigned rb[2], nb[2]; rb[0] = row_base(lane, 0); rb[1] = row_base(lane, 1); nb[0] = nat_base(lane, 0); nb[1] = nat_base(lane, 1);
    const int dc = w >> 1, ec0 = (w & 1) * 2;
    const int cc = w >> 1, tb = w & 1, rt = 32 * tb + r32;
    f32x16 C0, C1;
#pragma unroll
    for (int i = 0; i < 16; ++i) { C0[i] = 0.f; C1[i] = 0.f; }
    float mm = 0.f;
    { const u32x4 z = {0u, 0u, 0u, 0u};
      for (int o = tid * 16; o < 32768; o += 8192) *(LAS u32x4*)(lds + SO + o) = z;
      if (tid < 128) NIN[tid] = 0.f; }
    bf16x8 gqA[2], gkA[2], gvA[2], gqB[2], gkB[2], gvB[2]; float gbA, gtaA, gpmA, gblA, gmlA, gbB, gtaB, gpmB, gblB, gmlB;
#define MS_LOAD(X, S_) do { const int ch_ = stream_chunk(dir, b, (S_)); \
        _Pragma("unroll") for (int i_ = 0; i_ < 2; ++i_) { const bf16_t* p_ = c.Pb() + (size_t)proc_row(dir, ch_, srow + 32 * i_) * NP + hh * 128 + sch * 8; \
            gq##X[i_] = *(const bf16x8*)(p_ + D_Q); gk##X[i_] = *(const bf16x8*)(p_ + D_K); gv##X[i_] = *(const bf16x8*)(p_ + D_V); } \
        const size_t o_ = ((size_t)dir * MT + proc_row(dir, ch_, lane)) * 4 + hh; gb##X = c.MB()[o_]; gta##X = c.MLI()[o_]; gpm##X = c.MWU()[o_]; \
        gbl##X = c.MBL()[((size_t)dir * NCH + ch_) * 4 + hh]; gml##X = c.MML()[((size_t)dir * NCH + ch_) * 4 + hh]; } while (0)
    MS_LOAD(A, 0); MS_LOAD(B, 1);
    const bf16x8 ones = {0x3F80, 0x3F80, 0x3F80, 0x3F80, 0x3F80, 0x3F80, 0x3F80, 0x3F80};
    f32x16 hold; bf16_t* hptr = (bf16_t*)c.MH();
#pragma unroll
    for (int i = 0; i < 16; ++i) hold[i] = 0.f;
#define MS_STEP(X, S_) do { const int s = (S_); \
        const int m0 = stream_chunk(dir, b, s) * 64; \
          \
        const float bj = gb##X, ta = gta##X, bl = gbl##X, mt = bj + fmaxf(mm, gpm##X), winter = fexp_(bj + mm - mt), mn = fmaxf(bl + mm, gml##X), ws = fexp_(bl + mm - mn), wu = fexp_(bl + ta - mn); \
          \
        _Pragma("unroll") \
        for (int i = 0; i < 2; ++i) { const float wr = fa::bperm(wu, srow + 32 * i); f32x4 x0, x1; \
            _Pragma("unroll") \
            for (int j = 0; j < 4; ++j) { x0[j] = wr * bfe(gk##X[i], j); x1[j] = wr * bfe(gk##X[i], 4 + j); } \
            *(LAS bf16x8*)(lds + QO + soff + 8192 * i) = gq##X[i]; *(LAS bf16x8*)(lds + KO + soff + 8192 * i) = gk##X[i]; *(LAS bf16x8*)(lds + VO + soff + 8192 * i) = gv##X[i]; *(LAS bf16x8*)(lds + KT + soff + 8192 * i) = pack8f(x0, x1); } \
        if (w == 0) { TB[lane] = bj - mt; TA[lane] = ta; TWI[lane] = winter; TEI[lane] = fexp_(-mt); } \
        if (s > 0) { \
            _Pragma("unroll") \
            for (int g = 0; g < 4; ++g) { u32x2 o4; o4.x = pk2(hold[4 * g], hold[4 * g + 1]); o4.y = pk2(hold[4 * g + 2], hold[4 * g + 3]); *(u32x2*)(hptr + 8 * g) = o4; } } \
        if (s + 2 < NSC) MS_LOAD(X, s + 2); \
        __syncthreads(); \
        if (w < 4) {                                \
            const int st = w >> 1, tt = w & 1, r0 = 32 * tt + r32; f32x16 p; \
            _Pragma("unroll") \
            for (int i = 0; i < 16; ++i) p[i] = 0.f; \
            _Pragma("unroll") \
            for (int hf = 0; hf < 2; ++hf) { bf16x8 ka[4], qa[4]; \
                _Pragma("unroll") \
                for (int k = 0; k < 4; ++k) { const int s8 = 4 * hf + k; ka[k] = *(const LAS bf16x8*)(lds + KO + 8192 * st + rb[s8 & 1] + 512 * (s8 >> 1)); qa[k] = *(const LAS bf16x8*)(lds + QO + 8192 * tt + rb[s8 & 1] + 512 * (s8 >> 1)); } \
                _Pragma("unroll") \
                for (int k = 0; k < 4; ++k) p = __builtin_amdgcn_mfma_f32_32x32x16_bf16(ka[k], qa[k], p, 0, 0, 0); } \
            const float bt = TB[r0]; \
            _Pragma("unroll") \
            for (int g = 0; g < 4; ++g) { const f32x4 tav = *(const LAS f32x4*)(TA + 32 * st + 8 * g + 4 * h); float wv[4]; \
                _Pragma("unroll") \
                for (int j = 0; j < 4; ++j) { const int rs = 32 * st + 8 * g + 4 * h + j; wv[j] = rs <= r0 ? fexp_(bt + tav[j]) * p[4 * g + j] * SCALE : 0.f; } \
                u32x2 pk; pk.x = pk2(wv[0], wv[1]); pk.y = pk2(wv[2], wv[3]); \
                *(LAS u32x2*)(lds + WO + r0 * 144 + (32 * st + 8 * g + 4 * h) * 2) = pk; } \
        } else {                                    \
            const int t = (tid - 256) >> 2, part = tid & 3; float sacc = 0.f; \
            _Pragma("unroll") \
            for (int k = 0; k < 4; ++k) { const bf16x8 qv = *(const LAS bf16x8*)(lds + QO + off_a(t & 31, 4 * part + k) + 8192 * (t >> 5)); \
                const f32x4 n0 = *(const LAS f32x4*)(NIN + 32 * part + 8 * k), n1 = *(const LAS f32x4*)(NIN + 32 * part + 8 * k + 4); \
                _Pragma("unroll") \
                for (int j = 0; j < 4; ++j) sacc += bfe(qv, j) * n0[j] + bfe(qv, 4 + j) * n1[j]; } \
            sacc += fa::swz_xor<1>(sacc); sacc += fa::swz_xor<2>(sacc); \
            if (part == 0) QN[t] = sacc * SCALE; \
        } \
        __syncthreads(); \
        {                                            \
          _Pragma("unroll") \
          for (int i = 0; i < 16; ++i) hold[i] = 0.f; \
          _Pragma("unroll") \
          for (int hf = 0; hf < 2; ++hf) { bf16x8 ca[4], qa[4]; \
              _Pragma("unroll") \
              for (int k = 0; k < 4; ++k) { const int s8 = 4 * hf + k; ca[k] = tr_frag(lds, SO + 8192 * (s8 >> 1) + 4096 * (s8 & 1) + 512 * cc, nb); qa[k] = *(const LAS bf16x8*)(lds + QO + 8192 * tb + rb[s8 & 1] + 512 * (s8 >> 1)); } \
              _Pragma("unroll") \
              for (int k = 0; k < 4; ++k) hold = __builtin_amdgcn_mfma_f32_32x32x16_bf16(ca[k], qa[k], hold, 0, 0, 0); } \
          bf16x8 wa[4], va[4]; \
          _Pragma("unroll") \
          for (int k4 = 0; k4 < 4; ++k4) { wa[k4] = *(const LAS bf16x8*)(lds + WO + rt * 144 + (16 * k4 + 8 * h) * 2); va[k4] = tr_frag(lds, VO + 8192 * (k4 >> 1) + 4096 * (k4 & 1) + 512 * cc, nb); } \
          const float wi = TWI[rt], wsq = wi * SCALE; \
          _Pragma("unroll") \
          for (int i = 0; i < 16; ++i) hold[i] *= wsq; \
          float rsum = 0.f; \
          _Pragma("unroll") \
          for (int k4 = 0; k4 < 4; ++k4) { \
              _Pragma("unroll") \
              for (int j = 0; j < 8; ++j) rsum += bfe(wa[k4], j); \
              hold = __builtin_amdgcn_mfma_f32_32x32x16_bf16(va[k4], wa[k4], hold, 0, 0, 0); } \
          rsum = xhalf_sum(rsum); \
          const float den = wi * QN[rt] + rsum, rinv = 1.0f / fmaxf(fabsf(den), TEI[rt]); \
          hptr = (bf16_t*)c.MH() + ((size_t)dir * MT + m0 + (dir ? 63 - rt : rt)) * 512 + hh * 128 + 32 * cc + 4 * h; \
          _Pragma("unroll") \
          for (int i = 0; i < 16; ++i) hold[i] *= rinv; } \
        __syncthreads(); \
        { f32x16 d2; bf16x8 bk[4], a0[4], a1[4];     \
          _Pragma("unroll") \
          for (int ks = 0; ks < 4; ++ks) { bk[ks] = tr_frag(lds, KT + 8192 * (ks >> 1) + 4096 * (ks & 1) + 512 * dc, nb); \
              a0[ks] = tr_frag(lds, VO + 8192 * (ks >> 1) + 4096 * (ks & 1) + 512 * ec0, nb); a1[ks] = tr_frag(lds, VO + 8192 * (ks >> 1) + 4096 * (ks & 1) + 512 * (ec0 + 1), nb); } \
          _Pragma("unroll") \
          for (int i = 0; i < 16; ++i) { C0[i] *= ws; C1[i] *= ws; d2[i] = 0.f; } \
          _Pragma("unroll") \
          for (int ks = 0; ks < 4; ++ks) { C0 = __builtin_amdgcn_mfma_f32_32x32x16_bf16(a0[ks], bk[ks], C0, 0, 0, 0); C1 = __builtin_amdgcn_mfma_f32_32x32x16_bf16(a1[ks], bk[ks], C1, 0, 0, 0); } \
          if (ec0 == 0) { \
              _Pragma("unroll") \
              for (int ks = 0; ks < 4; ++ks) d2 = __builtin_amdgcn_mfma_f32_32x32x16_bf16(ones, bk[ks], d2, 0, 0, 0); \
              if (h == 0) NIN[32 * dc + r32] = ws * NIN[32 * dc + r32] + d2[0]; } \
          _Pragma("unroll") \
          for (int g = 0; g < 4; ++g) { u32x2 pk; pk.x = pk2(C0[4 * g], C0[4 * g + 1]); pk.y = pk2(C0[4 * g + 2], C0[4 * g + 3]); *(LAS u32x2*)(lds + SO + 8192 * dc + off_a(r32, 4 * ec0 + g) + 8 * h) = pk; \
              pk.x = pk2(C1[4 * g], C1[4 * g + 1]); pk.y = pk2(C1[4 * g + 2], C1[4 * g + 3]); *(LAS u32x2*)(lds + SO + 8192 * dc + off_a(r32, 4 * (ec0 + 1) + g) + 8 * h) = pk; } \
          mm = mn; } \
        __syncthreads(); \
    } while (0)
    static_assert(NSC % 2 == 0, "the stream loop is unrolled by two");
    for (int s2 = 0; s2 < NSC; s2 += 2) { MS_STEP(A, s2); MS_STEP(B, s2 + 1); }
#pragma unroll
    for (int g = 0; g < 4; ++g) { u32x2 o4; o4.x = pk2(hold[4 * g], hold[4 * g + 1]); o4.y = pk2(hold[4 * g + 2], hold[4 * g + 3]); *(u32x2*)(hptr + 8 * g) = o4; }
#undef MS_STEP
#undef MS_LOAD
}
constexpr int N_ML_STREAMS = 2 * B_ * 4;

DEV void hgrn_stream_unit(const Ctx& c, LAS unsigned char* lds, const int tid, const int unit) {
    constexpr int QO = 0, VO = 16384, KT = 32768, SO = 49152;
    const int lane = tid & 63, w = __builtin_amdgcn_readfirstlane(tid >> 6), r32 = lane & 31, h = lane >> 5;
    const int hh = unit & 3, b = (unit >> 2) & 3, dir = unit >> 4;
    const int srow = tid >> 4, sch = tid & 15; const unsigned soff = off_a(srow, sch);
    unsigned rb[2], nb[2]; rb[0] = row_base(lane, 0); rb[1] = row_base(lane, 1); nb[0] = nat_base(lane, 0); nb[1] = nat_base(lane, 1);
    const int dc = w >> 1, ec0 = (w & 1) * 2;
    const int cc = w >> 1, tb = w & 1, rt = 32 * tb + r32;
    f32x16 C0, C1;
#pragma unroll
    for (int i = 0; i < 16; ++i) { C0[i] = 0.f; C1[i] = 0.f; }
    { const u32x4 z = {0u, 0u, 0u, 0u};
      for (int o = tid * 16; o < 32768; o += 8192) *(LAS u32x4*)(lds + SO + o) = z; }
    f32x4 gb[2][2], gl[2]; bf16x8 gqb[2], gkb[2], gv[2]; float gdec;
#define HS_LOAD(S_) do { const int ch_ = stream_chunk(dir, b, (S_)); \
        _Pragma("unroll") for (int i_ = 0; i_ < 2; ++i_) { const int m_ = proc_row(dir, ch_, srow + 32 * i_); const size_t og_ = (size_t)m_ * 512 + hh * 128 + sch * 8, od_ = (size_t)dir * MT * 512 + og_; \
            gqb[i_] = *(const bf16x8*)(c.Pb() + (size_t)m_ * NP + A_Q + hh * 128 + sch * 8); gb[i_][0] = *(const f32x4*)(c.BC() + od_); gb[i_][1] = *(const f32x4*)(c.BC() + od_ + 4); \
            gkb[i_] = *(const bf16x8*)((const bf16_t*)c.KK() + od_); gv[i_] = *(const bf16x8*)(c.Pb() + (size_t)m_ * NP + A_I + hh * 128 + sch * 8); } \
        const float* blp_ = c.BL() + ((size_t)dir * NCH + ch_) * 512 + hh * 128; gl[0] = *(const f32x4*)(blp_ + sch * 8); gl[1] = *(const f32x4*)(blp_ + sch * 8 + 4); gdec = blp_[32 * dc + r32]; } while (0)
    HS_LOAD(0);
    for (int s = 0; s < NSC; ++s) {
        const int m0 = stream_chunk(dir, b, s) * 64;
#pragma unroll
        for (int i = 0; i < 2; ++i) { f32x4 x0, x1, y0, y1;
#pragma unroll
            for (int j = 0; j < 4; ++j) { x0[j] = fsilu_(bfe(gqb[i], j)) * 0.08838834764831845f * fexp_(gb[i][0][j]); x1[j] = fsilu_(bfe(gqb[i], 4 + j)) * 0.08838834764831845f * fexp_(gb[i][1][j]);
                y0[j] = bfe(gkb[i], j) * fexp_(gl[0][j] - gb[i][0][j]); y1[j] = bfe(gkb[i], 4 + j) * fexp_(gl[1][j] - gb[i][1][j]); }
            *(LAS bf16x8*)(lds + QO + soff + 8192 * i) = pack8f(x0, x1); *(LAS bf16x8*)(lds + KT + soff + 8192 * i) = pack8f(y0, y1); *(LAS bf16x8*)(lds + VO + soff + 8192 * i) = gv[i]; }
        const float dec = fexp_(gdec);
        if (s + 1 < NSC) HS_LOAD(s + 1);
        __syncthreads();
        { f32x16 acc;
#pragma unroll
          for (int i = 0; i < 16; ++i) acc[i] = 0.f;
#pragma unroll
          for (int hf = 0; hf < 2; ++hf) { bf16x8 ca[4], qa[4];
#pragma unroll
              for (int k = 0; k < 4; ++k) { const int s8 = 4 * hf + k; ca[k] = tr_frag(lds, SO + 8192 * (s8 >> 1) + 4096 * (s8 & 1) + 512 * cc, nb); qa[k] = *(const LAS bf16x8*)(lds + QO + 8192 * tb + rb[s8 & 1] + 512 * (s8 >> 1)); }
#pragma unroll
              for (int k = 0; k < 4; ++k) acc = __builtin_amdgcn_mfma_f32_32x32x16_bf16(ca[k], qa[k], acc, 0, 0, 0); }
          bf16_t* hp = (bf16_t*)c.HO() + ((size_t)dir * MT + m0 + (dir ? 63 - rt : rt)) * 512 + hh * 128 + 32 * cc + 4 * h;
#pragma unroll
          for (int g = 0; g < 4; ++g) { u32x2 o4; o4.x = pk2(acc[4 * g], acc[4 * g + 1]); o4.y = pk2(acc[4 * g + 2], acc[4 * g + 3]); *(u32x2*)(hp + 8 * g) = o4; } }
        __syncthreads();
        { bf16x8 bk[4], a0[4], a1[4];
#pragma unroll
          for (int ks = 0; ks < 4; ++ks) { bk[ks] = tr_frag(lds, KT + 8192 * (ks >> 1) + 4096 * (ks & 1) + 512 * dc, nb);
              a0[ks] = tr_frag(lds, VO + 8192 * (ks >> 1) + 4096 * (ks & 1) + 512 * ec0, nb); a1[ks] = tr_frag(lds, VO + 8192 * (ks >> 1) + 4096 * (ks & 1) + 512 * (ec0 + 1), nb); }
#pragma unroll
          for (int i = 0; i < 16; ++i) { C0[i] *= dec; C1[i] *= dec; }
#pragma unroll
          for (int ks = 0; ks < 4; ++ks) { C0 = __builtin_amdgcn_mfma_f32_32x32x16_bf16(a0[ks], bk[ks], C0, 0, 0, 0); C1 = __builtin_amdgcn_mfma_f32_32x32x16_bf16(a1[ks], bk[ks], C1, 0, 0, 0); }
#pragma unroll
          for (int g = 0; g < 4; ++g) { u32x2 pk; pk.x = pk2(C0[4 * g], C0[4 * g + 1]); pk.y = pk2(C0[4 * g + 2], C0[4 * g + 3]); *(LAS u32x2*)(lds + SO + 8192 * dc + off_a(r32, 4 * ec0 + g) + 8 * h) = pk;
              pk.x = pk2(C1[4 * g], C1[4 * g + 1]); pk.y = pk2(C1[4 * g + 2], C1[4 * g + 3]); *(LAS u32x2*)(lds + SO + 8192 * dc + off_a(r32, 4 * (ec0 + 1) + g) + 8 * h) = pk; } }
        __syncthreads();
    }
#undef HS_LOAD
}
constexpr int N_HG_STREAMS = 2 * B_ * 4;

DEV void hgrn_out2_unit(const Ctx& c, int l, LAS unsigned char* lds, const int tid, const int unit) {
    constexpr int QO = 0, VO = 16384, SO = 32768, WO = 65536, QT = 74752, KS = QT + 9216, BT = KS + 9216, OP = 102400, Q1 = OP, K1 = OP + 2560, Q2 = OP + 5120, K2 = OP + 7680;
    const int lane = tid & 63, w = __builtin_amdgcn_readfirstlane(tid >> 6), r32 = lane & 31, h = lane >> 5;
    const int hh = unit & 3, chunk = unit >> 2, m0 = chunk * 64;
    const int cc = w >> 1, tb = w & 1, rt = 32 * tb + r32; f32x16 tot;
#pragma unroll
    for (int i = 0; i < 16; ++i) tot[i] = 0.f;
    for (int dir = 0; dir < 2; ++dir) {
    const int uo = (dir * NCH + chunk) * 4 + hh;
    { const int srow = tid >> 4, sch = tid & 15; const unsigned soff = off_a(srow, sch);
#pragma unroll
      for (int i = 0; i < 2; ++i) { const int jr = srow + 32 * i, m = m0 + (dir ? 63 - jr : jr); *(LAS bf16x8*)(lds + VO + soff + 8192 * i) = *(const bf16x8*)(c.Pb() + (size_t)m * NP + A_I + hh * 128 + sch * 8); }
      const u32x4 z = {0u, 0u, 0u, 0u};
      for (int o = tid * 16; o < 9216; o += 8192) *(LAS u32x4*)(lds + WO + o) = z; }
    f32x16 accL;
#pragma unroll
    for (int i = 0; i < 16; ++i) accL[i] = 0.f;
    float ad0 = 0.f, ad1 = 0.f;
    const int db = w >> 1, qi = 64 * (w & 1) + lane, rp = qi >> 4, ci = qi & 15; int tl, sl; const bool two = rp == 7 && ci >= 8;
    if (rp < 7) { const bool sm = ci < rp + 1; tl = sm ? rp + 1 : 15 - rp; sl = sm ? ci : ci - (rp + 1); } else if (ci < 8) { tl = 8; sl = ci; } else { tl = 2 * (ci - 8); sl = tl; }
    const int dt = 16 * db + tl, ds0 = 16 * db + sl;
    const int prow = tid >> 3, pd4 = tid & 7, mrow = m0 + (dir ? 63 - prow : prow);
    const size_t og0 = (size_t)mrow * 512 + hh * 128 + pd4 * 4, od0 = (size_t)dir * MT * 512 + og0;
    const bf16_t* qsrc = c.Pb() + (size_t)mrow * NP + A_Q + hh * 128 + pd4 * 4; const bf16_t* ksrc = (const bf16_t*)c.KK() + od0;
#define HG_QK(DQ_) do { const u32x2 qr_ = *(const u32x2*)(qsrc + (DQ_) * 32), kr_ = *(const u32x2*)(ksrc + (DQ_) * 32); \
        gq = (f32x4){fsilu_(__builtin_bit_cast(float, qr_.x << 16)), fsilu_(__builtin_bit_cast(float, qr_.x & 0xffff0000u)), fsilu_(__builtin_bit_cast(float, qr_.y << 16)), fsilu_(__builtin_bit_cast(float, qr_.y & 0xffff0000u))} * 0.08838834764831845f; \
        gk = (f32x4){__builtin_bit_cast(float, kr_.x << 16), __builtin_bit_cast(float, kr_.x & 0xffff0000u), __builtin_bit_cast(float, kr_.y << 16), __builtin_bit_cast(float, kr_.y & 0xffff0000u)}; } while (0)
    f32x4 gq, gk, gb = *(const f32x4*)(c.BC() + od0); HG_QK(0);
    for (int dq = 0; dq < 4; ++dq) {
        const f32x4 b2 = gb * fa::LOG2E;
        *(LAS f32x4*)(lds + QT + (prow * 36 + pd4 * 4) * 4) = gq; *(LAS f32x4*)(lds + KS + (prow * 36 + pd4 * 4) * 4) = gk; *(LAS f32x4*)(lds + BT + (prow * 36 + pd4 * 4) * 4) = b2;
        __syncthreads();
        const f32x4 cq = gq, ck = gk;
        if (dq < 3) { HG_QK(dq + 1); gb = *(const f32x4*)(c.BC() + od0 + (dq + 1) * 32); }
        { const f32x4 r15 = *(const LAS f32x4*)(lds + BT + (15 * 36 + pd4 * 4) * 4), r31 = *(const LAS f32x4*)(lds + BT + (31 * 36 + pd4 * 4) * 4), r47 = *(const LAS f32x4*)(lds + BT + (47 * 36 + pd4 * 4) * 4);
#define HG_PUT(TILE, ROWL, VAL, EXPO) do { u32x2 pk_; pk_.x = pk2((VAL)[0] * __builtin_amdgcn_exp2f((EXPO)[0]), (VAL)[1] * __builtin_amdgcn_exp2f((EXPO)[1])); \
            pk_.y = pk2((VAL)[2] * __builtin_amdgcn_exp2f((EXPO)[2]), (VAL)[3] * __builtin_amdgcn_exp2f((EXPO)[3])); *(LAS u32x2*)(lds + (TILE) + (ROWL) * 80 + pd4 * 8) = pk_; } while (0)
          if (prow >= 32) { const f32x4 e = b2 - r31; HG_PUT(Q1, prow - 32, cq, e); } else { const f32x4 e = r31 - b2; HG_PUT(K1, prow, ck, e); }
          if (prow >= 48) { const f32x4 e = b2 - r47; HG_PUT(Q2, prow - 32, cq, e); } else if (prow >= 32) { const f32x4 e = r47 - b2; HG_PUT(K2, prow - 16, ck, e); }
          else if (prow >= 16) { const f32x4 e = b2 - r15; HG_PUT(Q2, prow - 16, cq, e); } else { const f32x4 e = r15 - b2; HG_PUT(K2, prow, ck, e); }
#undef HG_PUT
        }
#pragma unroll 2
        for (int d4 = 0; d4 < 8; ++d4) { const f32x4 qt = *(const LAS f32x4*)(lds + QT + (dt * 36 + d4 * 4) * 4), bt = *(const LAS f32x4*)(lds + BT + (dt * 36 + d4 * 4) * 4);
            const f32x4 k0 = *(const LAS f32x4*)(lds + KS + (ds0 * 36 + d4 * 4) * 4), b0 = *(const LAS f32x4*)(lds + BT + (ds0 * 36 + d4 * 4) * 4);
#pragma unroll
            for (int e = 0; e < 4; ++e) ad0 += qt[e] * k0[e] * __builtin_amdgcn_exp2f(bt[e] - b0[e]); }
        if (two) {
#pragma unroll 2
            for (int d4 = 0; d4 < 8; ++d4) { const f32x4 q1 = *(const LAS f32x4*)(lds + QT + ((dt + 1) * 36 + d4 * 4) * 4), k1 = *(const LAS f32x4*)(lds + KS + ((dt + 1) * 36 + d4 * 4) * 4);
#pragma unroll
                for (int e = 0; e < 4; ++e) ad1 += q1[e] * k1[e]; } }
        __syncthreads();
        if (w < 2) { const int qo = w == 0 ? Q1 : Q2, ko = w == 0 ? K1 : K2;
#pragma unroll
            for (int ks = 0; ks < 2; ++ks) { const bf16x8 a = *(const LAS bf16x8*)(lds + ko + r32 * 80 + (16 * ks + 8 * h) * 2), b = *(const LAS bf16x8*)(lds + qo + r32 * 80 + (16 * ks + 8 * h) * 2);
                accL = __builtin_amdgcn_mfma_f32_32x32x16_bf16(a, b, accL, 0, 0, 0); } }
    }
    if (w == 0) { const int t = 32 + r32;
#pragma unroll
        for (int g = 0; g < 4; ++g) { u32x2 pk; pk.x = pk2(accL[4 * g], accL[4 * g + 1]); pk.y = pk2(accL[4 * g + 2], accL[4 * g + 3]); *(LAS u32x2*)(lds + WO + t * 144 + (8 * g + 4 * h) * 2) = pk; } }
    else if (w == 1) { const bool lo = r32 < 16; const int t = lo ? 16 + r32 : 32 + r32;
#pragma unroll
        for (int g = 0; g < 4; ++g) { const bool mine = lo ? g < 2 : g >= 2; const int s = (lo ? 0 : 16) + 8 * g + 4 * h;
            if (mine) { u32x2 pk; pk.x = pk2(accL[4 * g], accL[4 * g + 1]); pk.y = pk2(accL[4 * g + 2], accL[4 * g + 3]); *(LAS u32x2*)(lds + WO + t * 144 + s * 2) = pk; } } }
    *(LAS bf16_t*)(lds + WO + dt * 144 + ds0 * 2) = f2bf(ad0);
    if (two) *(LAS bf16_t*)(lds + WO + (dt + 1) * 144 + (dt + 1) * 2) = f2bf(ad1);
    __syncthreads();
    { unsigned nb[2]; nb[0] = nat_base(lane, 0); nb[1] = nat_base(lane, 1);
      const int jrow = dir ? 63 - rt : rt;
#pragma unroll
      for (int k4 = 0; k4 < 4; ++k4) { const bf16x8 b = *(const LAS bf16x8*)(lds + WO + jrow * 144 + (16 * k4 + 8 * h) * 2);
          const bf16x8 av = tr_frag(lds, VO + 8192 * (k4 >> 1) + 4096 * (k4 & 1) + 512 * cc, nb);
          tot = __builtin_amdgcn_mfma_f32_32x32x16_bf16(av, b, tot, 0, 0, 0); } }
    __syncthreads();
    }
    { bf16_t* hi = (bf16_t*)c.HST() + (size_t)(m0 + rt) * 512 + hh * 128 + 32 * cc + 4 * h;
#pragma unroll
      for (int g = 0; g < 4; ++g) { u32x2 o4; o4.x = pk2(tot[4 * g], tot[4 * g + 1]); o4.y = pk2(tot[4 * g + 2], tot[4 * g + 3]); *(u32x2*)(hi + 8 * g) = o4; } }
    __syncthreads();
}
constexpr int N_CH_UNITS = 2 * NCH * 4, N_CH2_UNITS = NCH * 4;
}
namespace thin {
using fa::pk2; using fa::u32x2; using fa::u32x4; using fa::bf16x8; using ch::f32x4; using ch::bfe;
DEV float wave_sum(float v) { v += fa::swz_xor<1>(v); v += fa::swz_xor<2>(v); v += fa::swz_xor<4>(v); v += fa::swz_xor<8>(v); v += fa::swz_xor<16>(v); return fa::xhalf_sum(v); }
DEV float wave_max(float v) { v = fmaxf(v, fa::swz_xor<1>(v)); v = fmaxf(v, fa::swz_xor<2>(v)); v = fmaxf(v, fa::swz_xor<4>(v)); v = fmaxf(v, fa::swz_xor<8>(v)); v = fmaxf(v, fa::swz_xor<16>(v)); return fa::xhalf_max(v); }
static_assert(D_ == 2048, "row stages are written for d_model 2048");

DEV void unpack8(const u32x4 r, f32x4& a, f32x4& b) {
    a = (f32x4){__builtin_bit_cast(float, r.x << 16), __builtin_bit_cast(float, r.x & 0xffff0000u), __builtin_bit_cast(float, r.y << 16), __builtin_bit_cast(float, r.y & 0xffff0000u)};
    b = (f32x4){__builtin_bit_cast(float, r.z << 16), __builtin_bit_cast(float, r.z & 0xffff0000u), __builtin_bit_cast(float, r.w << 16), __builtin_bit_cast(float, r.w & 0xffff0000u)}; }
DEV u32x4 pack8v(const f32x4 a, const f32x4 b) { u32x4 p; p.x = pk2(a[0], a[1]); p.y = pk2(a[2], a[3]); p.z = pk2(b[0], b[1]); p.w = pk2(b[2], b[3]); return p; }
template <int NR>
DEV void mod_row(const Ctx& c, int l, int which, int m0, int lane, int np, const float* pg) {
    bf16_t* x = c.XB() + (size_t)m0 * D_ + 8 * lane; f32x4 v[NR][4][2];
    if (l == 0 && which == 0) {
        const float* xi = (m0 < MX ? c.x_in() + (size_t)m0 * D_ : c.ctx_in() + (size_t)(m0 - MX) * D_) + 8 * lane;
#pragma unroll
        for (int r = 0; r < NR; ++r)
#pragma unroll
            for (int i = 0; i < 4; ++i) { v[r][i][0] = *(const f32x4*)(xi + r * D_ + 512 * i); v[r][i][1] = *(const f32x4*)(xi + r * D_ + 512 * i + 4); if (m0 >= MX) *(u32x4*)(x + r * D_ + 512 * i) = pack8v(v[r][i][0], v[r][i][1]); }
    } else {
#pragma unroll
        for (int r = 0; r < NR; ++r)
#pragma unroll
            for (int i = 0; i < 4; ++i) unpack8(*(const u32x4*)(x + r * D_ + 512 * i), v[r][i][0], v[r][i][1]);
    }
    if (m0 >= MX && np > 0) { const bf16_t* pp = (const bf16_t*)c.PARTS() + (size_t)(m0 - MX) * D_ + 8 * lane;
#pragma unroll
        for (int r = 0; r < NR; ++r)
#pragma unroll
            for (int i = 0; i < 4; ++i) { f32x4 s0, s1; unpack8(*(const u32x4*)(pp + r * D_ + 512 * i), s0, s1);
                for (int k = 1; k < np; ++k) { f32x4 t0, t1; unpack8(*(const u32x4*)(pp + (size_t)k * MCX * D_ + r * D_ + 512 * i), t0, t1); s0 = s0 + t0; s1 = s1 + t1; }
                v[r][i][0] = v[r][i][0] + *(const f32x4*)(pg + 8 * lane + 512 * i) * s0; v[r][i][1] = v[r][i][1] + *(const f32x4*)(pg + 8 * lane + 512 * i + 4) * s1;
                *(u32x4*)(x + r * D_ + 512 * i) = pack8v(v[r][i][0], v[r][i][1]); } }
    const float* md = c.MOD() + ((size_t)l * NV + row_vec(m0)) * D6 + which * 3 * D_ + 8 * lane;
#pragma unroll
    for (int r = 0; r < NR; ++r) { float ss = 0.f;
#pragma unroll
        for (int i = 0; i < 4; ++i)
#pragma unroll
            for (int q = 0; q < 2; ++q) ss += v[r][i][q][0] * v[r][i][q][0] + v[r][i][q][1] * v[r][i][q][1] + v[r][i][q][2] * v[r][i][q][2] + v[r][i][q][3] * v[r][i][q][3];
        ss = wave_sum(ss); const float rr = 1.0f / sqrtf(ss * (1.0f / D_) + EPS_); bf16_t* hp = c.Hb() + (size_t)(m0 + r) * D_ + 8 * lane;
#pragma unroll
        for (int i = 0; i < 4; ++i) { const f32x4 sh0 = *(const f32x4*)(md + 512 * i), sh1 = *(const f32x4*)(md + 512 * i + 4), sc0 = *(const f32x4*)(md + D_ + 512 * i), sc1 = *(const f32x4*)(md + D_ + 512 * i + 4);
            *(u32x4*)(hp + 512 * i) = pack8v(v[r][i][0] * rr * (sc0 + 1.0f) + sh0, v[r][i][1] * rr * (sc1 + 1.0f) + sh1); } }
}
template <int INL>
DEV void modp4(const Ctx& c, long i) {
    constexpr int C4 = D6 / 4, KL = D_ / KPARTS; const int c4 = (int)(i % C4), kp = (int)((i / C4) % KPARTS), l = (int)(i / ((long)C4 * KPARTS)), col = c4 * 4;
    f32x4 acc[NV];
#pragma unroll
    for (int v = 0; v < NV; ++v) acc[v] = (f32x4){0.f, 0.f, 0.f, 0.f};
    const float* wp = c.w_ada() + ((size_t)l * D_ + kp * KL) * D6 + col; const float* sp = c.SC() + kp * KL;
    for (int k = 0; k < KL; k += 8) { f32x4 w[8];
#pragma unroll
        for (int j = 0; j < 8; ++j) w[j] = *(const f32x4*)(wp + (size_t)(k + j) * D6);
#pragma unroll
        for (int j = 0; j < 8; ++j)
#pragma unroll
            for (int v = 0; v < NV; ++v) { const float sv = INL ? fsilu_(v < B_ ? c.c_in()[v * D_ + kp * KL + k + j] : c.c_ctx()[kp * KL + k + j]) : sp[v * D_ + k + j]; acc[v] = acc[v] + w[j] * sv; } }
#pragma unroll
    for (int v = 0; v < NV; ++v) *(f32x4*)(c.MODP() + (((size_t)l * KPARTS + kp) * NV + v) * D6 + col) = acc[v];
}
DEV void final_row(const Ctx& c, int p, int lane) {
    constexpr int NR = 4; const bf16_t* x = c.XB() + (size_t)(NR * p) * D_ + 8 * lane; f32x4 v[NR][4][2];
#pragma unroll
    for (int r = 0; r < NR; ++r)
#pragma unroll
        for (int i = 0; i < 4; ++i) unpack8(*(const u32x4*)(x + r * D_ + 512 * i), v[r][i][0], v[r][i][1]);
#pragma unroll
    for (int r = 0; r < NR; ++r) { float ss = 0.f;
#pragma unroll
        for (int i = 0; i < 4; ++i)
#pragma unroll
            for (int q = 0; q < 2; ++q) ss += v[r][i][q][0] * v[r][i][q][0] + v[r][i][q][1] * v[r][i][q][1] + v[r][i][q][2] * v[r][i][q][2] + v[r][i][q][3] * v[r][i][q][3];
        ss = wave_sum(ss); const float rr = 1.0f / sqrtf(ss * (1.0f / D_) + EPS_);
#pragma unroll
        for (int i = 0; i < 4; ++i)
#pragma unroll
            for (int q = 0; q < 2; ++q) { const f32x4 w = *(const f32x4*)(c.final_norm_w() + 8 * lane + 512 * i + 4 * q); *(f32x4*)(c.out() + (size_t)(NR * p + r) * D_ + 8 * lane + 512 * i + 4 * q) = v[r][i][q] * rr * w; } }
}
DEV void hgrn_gate(const Ctx& c, int l, long it, int lane) {
    const int hh = (int)(it & 3), m = (int)(it >> 2); const size_t o = (size_t)m * 512 + hh * 128 + 2 * lane;
    const float2 a = *(const float2*)(c.HO() + o), b = *(const float2*)(c.HO() + (size_t)MT * 512 + o); const float o0 = a.x + b.x, o1 = a.y + b.y;
    const float ss = wave_sum(o0 * o0 + o1 * o1), r = 1.0f / sqrtf(ss * (1.0f / 128.f) + EPS_);
    const float2 w = *(const float2*)(c.hgrn_norm_w() + l * 512 + hh * 128 + 2 * lane); const unsigned gg = *(const unsigned*)(c.Pb() + (size_t)m * NP + A_G + hh * 128 + 2 * lane);
    const float g0 = bf2f((bf16_t)(gg & 0xffffu)), g1 = bf2f((bf16_t)(gg >> 16));
    *(unsigned*)(c.Y() + (size_t)m * DMIX + hh * 128 + 2 * lane) = pk2(o0 * r * w.x * fsilu_(g0), o1 * r * w.y * fsilu_(g1));
}
DEV void mlstm_gate(const Ctx& c, int l, long it, int lane) {
    const int hh = (int)(it & 3), m = (int)(it >> 2); const size_t o = (size_t)m * 512 + hh * 128 + 2 * lane;
    const float2 a = *(const float2*)(c.MH() + o), b = *(const float2*)(c.MH() + (size_t)MT * 512 + o);
    const unsigned gg = *(const unsigned*)(c.Pb() + (size_t)m * NP + D_O + hh * 128 + 2 * lane);
    const float v0 = fsig_(bf2f((bf16_t)(gg & 0xffffu))) * (a.x + b.x), v1 = fsig_(bf2f((bf16_t)(gg >> 16))) * (a.y + b.y);
    const float ss = wave_sum(v0 * v0 + v1 * v1), r = 1.0f / sqrtf(ss * (1.0f / 128.f) + EPS_);
    const float2 w = *(const float2*)(c.mlstm_norm_w() + l * 512 + hh * 128 + 2 * lane);
    *(unsigned*)(c.Y() + (size_t)m * DMIX + 1536 + hh * 128 + 2 * lane) = pk2(v0 * r * w.x, v1 * r * w.y);
}
DEV void post8(const Ctx& c, int l, long i) {
    const int c8 = (int)(i & 15), hh = (int)((i >> 4) & 3), m = (int)(i >> 6); const size_t o = (size_t)m * 512 + hh * 128 + c8 * 8;
    const u32x4 ra = *(const u32x4*)((const bf16_t*)c.HO() + o), rb = *(const u32x4*)((const bf16_t*)c.HO() + (size_t)MT * 512 + o), ri = *(const u32x4*)((const bf16_t*)c.HST() + o);
    const u32x4 sa = *(const u32x4*)((const bf16_t*)c.MH() + o), sb = *(const u32x4*)((const bf16_t*)c.MH() + (size_t)MT * 512 + o);
    const bf16x8 gh = *(const bf16x8*)(c.Pb() + (size_t)m * NP + A_G + hh * 128 + c8 * 8), gm = *(const bf16x8*)(c.Pb() + (size_t)m * NP + D_O + hh * 128 + c8 * 8);
    { f32x4 a0, a1, b0, b1, i0, i1; unpack8(ra, a0, a1); unpack8(rb, b0, b1); unpack8(ri, i0, i1);
      float v[8], ss = 0.f;
#pragma unroll
      for (int j = 0; j < 4; ++j) { v[j] = a0[j] + b0[j] + i0[j]; v[4 + j] = a1[j] + b1[j] + i1[j]; ss += v[j] * v[j] + v[4 + j] * v[4 + j]; }
      ss += fa::swz_xor<1>(ss); ss += fa::swz_xor<2>(ss); ss += fa::swz_xor<4>(ss); ss += fa::swz_xor<8>(ss);
      const float r = 1.0f / sqrtf(ss * (1.0f / 128.f) + EPS_);
      const float* nw = c.hgrn_norm_w() + l * 512 + hh * 128 + c8 * 8; const f32x4 w0 = *(const f32x4*)nw, w1 = *(const f32x4*)(nw + 4);
      u32x4 pk; pk.x = pk2(v[0] * r * w0[0] * fsilu_(bfe(gh, 0)), v[1] * r * w0[1] * fsilu_(bfe(gh, 1))); pk.y = pk2(v[2] * r * w0[2] * fsilu_(bfe(gh, 2)), v[3] * r * w0[3] * fsilu_(bfe(gh, 3)));
      pk.z = pk2(v[4] * r * w1[0] * fsilu_(bfe(gh, 4)), v[5] * r * w1[1] * fsilu_(bfe(gh, 5))); pk.w = pk2(v[6] * r * w1[2] * fsilu_(bfe(gh, 6)), v[7] * r * w1[3] * fsilu_(bfe(gh, 7)));
      *(u32x4*)(c.Y() + (size_t)m * DMIX + hh * 128 + c8 * 8) = pk; }
    { f32x4 a0, a1, b0, b1; unpack8(sa, a0, a1); unpack8(sb, b0, b1);
      float v[8], ss = 0.f;
#pragma unroll
      for (int j = 0; j < 4; ++j) { v[j] = fsig_(bfe(gm, j)) * (a0[j] + b0[j]); v[4 + j] = fsig_(bfe(gm, 4 + j)) * (a1[j] + b1[j]); ss += v[j] * v[j] + v[4 + j] * v[4 + j]; }
      ss += fa::swz_xor<1>(ss); ss += fa::swz_xor<2>(ss); ss += fa::swz_xor<4>(ss); ss += fa::swz_xor<8>(ss);
      const float r = 1.0f / sqrtf(ss * (1.0f / 128.f) + EPS_);
      const float* nw = c.mlstm_norm_w() + l * 512 + hh * 128 + c8 * 8; const f32x4 w0 = *(const f32x4*)nw, w1 = *(const f32x4*)(nw + 4);
      u32x4 pk; pk.x = pk2(v[0] * r * w0[0], v[1] * r * w0[1]); pk.y = pk2(v[2] * r * w0[2], v[3] * r * w0[3]); pk.z = pk2(v[4] * r * w1[0], v[5] * r * w1[1]); pk.w = pk2(v[6] * r * w1[2], v[7] * r * w1[3]);
      *(u32x4*)(c.Y() + (size_t)m * DMIX + 1536 + hh * 128 + c8 * 8) = pk; }
}
DEV void mlstm_gates(const Ctx& c, int l, long it, int lane) {
    const int hh = (int)(it & 3), chunk = (int)((it >> 2) % NCH), dir = (int)((it >> 2) / NCH); const int m = proc_row(dir, chunk, lane);
    const float* g = c.G() + (size_t)m * 16; const float li = g[(2 * dir) * 4 + hh]; const float zf = g[(2 * dir + 1) * 4 + hh] + c.mlstm_f_bias()[(l * 2 + dir) * 4 + hh]; float v = fminf(zf, 0.f) - flog_(1.0f + fexp_(-fabsf(zf)));
#pragma unroll
    for (int o = 1; o < 64; o <<= 1) { const float t = fa::bperm(v, lane - o); if (lane >= o) v += t; }
    const float bl = fa::bperm(v, 63), ta = li - v, ml = wave_max(bl + ta); float pm = ta;
#pragma unroll
    for (int o = 1; o < 64; o <<= 1) { const float t = fa::bperm(pm, lane - o); if (lane >= o) pm = fmaxf(pm, t); }
    const size_t o = ((size_t)dir * MT + m) * 4 + hh; c.MB()[o] = v; c.MLI()[o] = ta; c.MWU()[o] = pm;
    if (lane == 0) { c.MBL()[((size_t)dir * NCH + chunk) * 4 + hh] = bl; c.MML()[((size_t)dir * NCH + chunk) * 4 + hh] = ml; }
}
DEV void hgrn_prep8(const Ctx& c, int l, long i) {
    const int c8 = (int)(i & 63), m = (int)(i >> 6), col = c8 * 8; const bf16_t* p = c.Pb() + (size_t)m * NP + col;
    const bf16x8 q = *(const bf16x8*)(p + A_Q); f32x4 q0, q1;
#pragma unroll
    for (int j = 0; j < 4; ++j) { q0[j] = fsilu_(bfe(q, j)) * 0.08838834764831845f; q1[j] = fsilu_(bfe(q, 4 + j)) * 0.08838834764831845f; }
    *(f32x4*)(c.QH() + (size_t)m * 512 + col) = q0; *(f32x4*)(c.QH() + (size_t)m * 512 + col + 4) = q1;
#pragma unroll
    for (int dir = 0; dir < 2; ++dir) { const bf16x8 z = *(const bf16x8*)(p + A_ZF + dir * 512); const float* lb = c.LBV() + (l * 2 + dir) * 512 + col; f32x4 k0, k1, b0, b1;
#pragma unroll
        for (int j = 0; j < 4; ++j) { k0[j] = (1.0f - lb[j]) * fsig_(-bfe(z, j)); k1[j] = (1.0f - lb[4 + j]) * fsig_(-bfe(z, 4 + j)); b0[j] = log1pf(-k0[j]); b1[j] = log1pf(-k1[j]); }
        const size_t o = ((size_t)dir * MT + m) * 512 + col;
        *(f32x4*)(c.KK() + o) = k0; *(f32x4*)(c.KK() + o + 4) = k1; *(f32x4*)(c.BC() + o) = b0; *(f32x4*)(c.BC() + o + 4) = b1; }
}
DEV void hgrn_decay_scan(const Ctx& c, int l, long i) {
    const int col = (int)(i % 512), chunk = (int)((i / 512) % NCH), dir = (int)(i / (512L * NCH)); const float lb0 = c.LBV()[(l * 2 + dir) * 512 + col], lb1 = 1.0f - lb0; float s = 0.f;
    const bf16_t* zp = c.Pb() + (size_t)chunk * 64 * NP + A_ZF + dir * 512 + col; const size_t ob = ((size_t)dir * MT + chunk * 64) * 512 + col;
    bf16_t z[64];
#pragma unroll
    for (int j = 0; j < 64; ++j) { const int r = dir ? 63 - j : j; z[j] = zp[(size_t)r * NP]; }
    { constexpr int jb = 0;
#pragma unroll
        for (int j = 0; j < 64; ++j) { const int r = dir ? 63 - (jb + j) : jb + j; const float zz = bf2f(z[j]), kk = lb1 * fsig_(-zz); s += flog_(lb0 + lb1 * fsig_(zz));        ((bf16_t*)c.KK())[ob + (size_t)r * 512] = f2bf(kk); c.BC()[ob + (size_t)r * 512] = s; } }
    c.BL()[((size_t)dir * NCH + chunk) * 512 + col] = s;
}
DEV void hgrn_q8(const Ctx& c, long i) {
    const int c8 = (int)(i & 63), m = (int)(i >> 6), col = c8 * 8; const bf16x8 q = *(const bf16x8*)(c.Pb() + (size_t)m * NP + A_Q + col); f32x4 q0, q1;
#pragma unroll
    for (int j = 0; j < 4; ++j) { q0[j] = fsilu_(bfe(q, j)) * 0.08838834764831845f; q1[j] = fsilu_(bfe(q, 4 + j)) * 0.08838834764831845f; }
    *(f32x4*)(c.QH() + (size_t)m * 512 + col) = q0; *(f32x4*)(c.QH() + (size_t)m * 512 + col + 4) = q1;
}
constexpr int CONV_J8 = FF_ / 8, CONV_STRIPS = (256 * 512) / CONV_J8;
DEV void conv_strip(const Ctx& c, int l, long i, int mrows) {
    const int j8 = (int)(i % CONV_J8), strip = (int)(i / CONV_J8), col = j8 * 8;
    float wa[3][8], wg[3][8], ba[8], bg[8];
#pragma unroll
    for (int t = 0; t < 3; ++t)
#pragma unroll
        for (int h2 = 0; h2 < 2; ++h2) { const f32x4 a = *(const f32x4*)(c.conv_w() + ((size_t)l * 3 + t) * FF2 + col + h2 * 4), g = *(const f32x4*)(c.conv_w() + ((size_t)l * 3 + t) * FF2 + FF_ + col + h2 * 4);
#pragma unroll
            for (int j = 0; j < 4; ++j) { wa[t][h2 * 4 + j] = a[j]; wg[t][h2 * 4 + j] = g[j]; } }
#pragma unroll
    for (int h2 = 0; h2 < 2; ++h2) { const f32x4 a = *(const f32x4*)(c.conv_b() + (size_t)l * FF2 + col + h2 * 4), g = *(const f32x4*)(c.conv_b() + (size_t)l * FF2 + FF_ + col + h2 * 4);
#pragma unroll
        for (int j = 0; j < 4; ++j) { ba[h2 * 4 + j] = a[j]; bg[h2 * 4 + j] = g[j]; } }
    const bf16x8 zero = {0, 0, 0, 0, 0, 0, 0, 0};
    for (int rb = strip; rb < mrows / 4; rb += CONV_STRIPS) {
        const int m0 = rb * 4, pos0 = row_pos(m0), len = row_len(m0);
        bf16x8 ua[6], ug[6];
#pragma unroll
        for (int r = 0; r < 6; ++r) { const bool ok = pos0 + r - 1 >= 0 && pos0 + r - 1 < len; const bf16_t* up = c.U() + (size_t)(m0 + r - 1) * FF2 + col;
            ua[r] = ok ? *(const bf16x8*)up : zero; ug[r] = ok ? *(const bf16x8*)(up + FF_) : zero; }
#pragma unroll
        for (int r = 0; r < 4; ++r) { float o[8];
#pragma unroll
            for (int j = 0; j < 8; ++j) { const float a = ba[j] + wa[0][j] * bfe(ua[r], j) + wa[1][j] * bfe(ua[r + 1], j) + wa[2][j] * bfe(ua[r + 2], j), g = bg[j] + wg[0][j] * bfe(ug[r], j) + wg[1][j] * bfe(ug[r + 1], j) + wg[2][j] * bfe(ug[r + 2], j); o[j] = fsilu_(a) * g; }
            u32x4 pk; pk.x = pk2(o[0], o[1]); pk.y = pk2(o[2], o[3]); pk.z = pk2(o[4], o[5]); pk.w = pk2(o[6], o[7]);
            *(u32x4*)(c.ACT() + (size_t)(m0 + r) * FF_ + col) = pk; } }
}
DEV void rope16(const Ctx& c, long i) {
    const int half = (int)(i & 1), blk = (int)((i >> 1) & 7), which = (int)((i >> 4) & 1), m = (int)(i >> 5); const int base = which * 512 + blk * 64 + half * 32;
    const bf16_t* p = c.Pb() + (size_t)m * NP + B_Q + base; bf16_t* q = c.QKB() + (size_t)m * 1024 + base;
    const bf16x8 a0 = *(const bf16x8*)p, a1 = *(const bf16x8*)(p + 8), b0 = *(const bf16x8*)(p + 16), b1 = *(const bf16x8*)(p + 24);
    if (m >= MX) { *(bf16x8*)q = a0; *(bf16x8*)(q + 8) = a1; *(bf16x8*)(q + 16) = b0; *(bf16x8*)(q + 24) = b1; return; }
    const int t = m % T_, pos = half ? t % GW : t / GW; const float* tb = c.ROPE() + pos * 32;
    float oa[16], ob[16];
#pragma unroll
    for (int k = 0; k < 16; ++k) { const float va = k < 8 ? bfe(a0, k) : bfe(a1, k - 8), vb = k < 8 ? bfe(b0, k) : bfe(b1, k - 8), cs = tb[2 * k], sn = tb[2 * k + 1]; oa[k] = va * cs - vb * sn; ob[k] = vb * cs + va * sn; }
    u32x4 w; w.x = pk2(oa[0], oa[1]); w.y = pk2(oa[2], oa[3]); w.z = pk2(oa[4], oa[5]); w.w = pk2(oa[6], oa[7]); *(u32x4*)q = w;
    w.x = pk2(oa[8], oa[9]); w.y = pk2(oa[10], oa[11]); w.z = pk2(oa[12], oa[13]); w.w = pk2(oa[14], oa[15]); *(u32x4*)(q + 8) = w;
    w.x = pk2(ob[0], ob[1]); w.y = pk2(ob[2], ob[3]); w.z = pk2(ob[4], ob[5]); w.w = pk2(ob[6], ob[7]); *(u32x4*)(q + 16) = w;
    w.x = pk2(ob[8], ob[9]); w.y = pk2(ob[10], ob[11]); w.z = pk2(ob[12], ob[13]); w.w = pk2(ob[14], ob[15]); *(u32x4*)(q + 24) = w;
}
DEV void hgrn_scan4(const Ctx& c, long i) {
    const int e4 = (int)(i & 31), d = (int)((i >> 5) & 127), hh = (int)((i >> 12) & 3), b = (int)((i >> 14) % B_), dir = (int)((i >> 14) / B_);
    f32x4 S = {0.f, 0.f, 0.f, 0.f};
    int chunk = stream_chunk(dir, b, 0); float* p = c.HST() + (((size_t)dir * NCH + chunk) * 4 + hh) * 16384 + d * 128 + e4 * 4; f32x4 t = *(const f32x4*)p; float dec = c.BL()[((size_t)dir * NCH + chunk) * 512 + hh * 128 + d];
    for (int s = 0; s < NSC; ++s) { float* pn = p; f32x4 tn = t; float decn = dec;
        if (s + 1 < NSC) { const int cn = stream_chunk(dir, b, s + 1); pn = c.HST() + (((size_t)dir * NCH + cn) * 4 + hh) * 16384 + d * 128 + e4 * 4; tn = *(const f32x4*)pn; decn = c.BL()[((size_t)dir * NCH + cn) * 512 + hh * 128 + d]; }
        { u32x2 pk; pk.x = pk2(S[0], S[1]); pk.y = pk2(S[2], S[3]); *(u32x2*)(c.HSB() + (p - c.HST())) = pk; } S = S * fexp_(dec) + t; p = pn; t = tn; dec = decn; }
}
DEV void mlstm_scan4(const Ctx& c, long i) {
    const int e4 = (int)(i & 31), d = (int)((i >> 5) & 127), hh = (int)((i >> 12) & 3), b = (int)((i >> 14) % B_), dir = (int)((i >> 14) / B_);
    f32x4 C = {0.f, 0.f, 0.f, 0.f}; float n = 0.f, mm = 0.f;
    int chunk = stream_chunk(dir, b, 0); size_t oc = ((size_t)dir * NCH + chunk) * 4 + hh; float* p = c.MCs() + oc * 16384 + d * 128 + e4 * 4; f32x4 t = *(const f32x4*)p;
    for (int s = 0; s < NSC; ++s) { float* pn = p; f32x4 tn = t; size_t ocn = oc;
        if (s + 1 < NSC) { const int cn = stream_chunk(dir, b, s + 1); ocn = ((size_t)dir * NCH + cn) * 4 + hh; pn = c.MCs() + ocn * 16384 + d * 128 + e4 * 4; tn = *(const f32x4*)pn; }
        const float bl = c.MBL()[oc], ml = c.MML()[oc], mn = fmaxf(bl + mm, ml), ws = fexp_(bl + mm - mn), wl = fexp_(ml - mn);
        { u32x2 pk; pk.x = pk2(C[0], C[1]); pk.y = pk2(C[2], C[3]); *(u32x2*)(c.MSB() + (p - c.MCs())) = pk; } C = C * ws + t * wl;
        if (e4 == 0) { float* q = c.MN() + oc * 128 + d; const float tq = *q; *q = n; n = ws * n + wl * tq; if (d == 0) c.MMIN()[oc] = mm; }
        mm = mn; p = pn; t = tn; oc = ocn; }
}
}
constexpr int LDS_BYTES = 147456, MISC_OFF = 131072;
constexpr int CW_BAR = 1024;

struct EpiP {
    static constexpr bool PERM = true, AFTER_DRAIN = false;
    bf16_t* P; float* G;
    __device__ __forceinline__ void operator()(const pg8::f32x4 (&acc)[2][2][4][2], const pg8::Unit& u, int wr, int wc, int fr, int fq) const {
        const int row0 = u.pm * 256 + wr * 64 + fr;
        if (u.pn < NP / 256) {
            const int col0 = u.pn * 256 + wc * 32 + 8 * fq;
#pragma unroll
            for (int ai = 0; ai < 2; ++ai)
#pragma unroll
                for (int m = 0; m < 4; ++m) { bf16_t* rowp = P + (size_t)(row0 + ai * 128 + m * 16) * NP + col0;
#pragma unroll
                    for (int bj = 0; bj < 2; ++bj) { const pg8::f32x4 v0 = acc[ai][bj][m][0], v1 = acc[ai][bj][m][1];
                        pg8::u32x4 w; w.x = pg8::cvt_pk_bf16(v0[0], v0[1]); w.y = pg8::cvt_pk_bf16(v0[2], v0[3]); w.z = pg8::cvt_pk_bf16(v1[0], v1[1]); w.w = pg8::cvt_pk_bf16(v1[2], v1[3]);
                        *(pg8::u32x4*)(rowp + bj * 128) = w; } }
        } else if (wc == 0 && fq < 2) {
#pragma unroll
            for (int ai = 0; ai < 2; ++ai)
#pragma unroll
                for (int m = 0; m < 4; ++m) { float* rowp = G + (size_t)(row0 + ai * 128 + m * 16) * 16 + 8 * fq;
                    *(pg8::f32x4*)(rowp) = acc[ai][0][m][0]; *(pg8::f32x4*)(rowp + 4) = acc[ai][0][m][1]; }
        }
    }
};
struct EpiU {
    static constexpr bool PERM = true, AFTER_DRAIN = false;
    bf16_t* O;
    __device__ __forceinline__ void operator()(const pg8::f32x4 (&acc)[2][2][4][2], const pg8::Unit& u, int wr, int wc, int fr, int fq) const {
        const int row0 = u.pm * 256 + wr * 64 + fr, col0 = u.pn * 256 + wc * 32 + 8 * fq;
#pragma unroll
        for (int ai = 0; ai < 2; ++ai)
#pragma unroll
            for (int m = 0; m < 4; ++m) { bf16_t* rowp = O + (size_t)(row0 + ai * 128 + m * 16) * FF2 + col0;
#pragma unroll
                for (int bj = 0; bj < 2; ++bj) { const pg8::f32x4 v0 = acc[ai][bj][m][0], v1 = acc[ai][bj][m][1];
                    pg8::u32x4 w; w.x = pg8::cvt_pk_bf16(v0[0], v0[1]); w.y = pg8::cvt_pk_bf16(v0[2], v0[3]); w.z = pg8::cvt_pk_bf16(v1[0], v1[1]); w.w = pg8::cvt_pk_bf16(v1[2], v1[3]);
                    *(pg8::u32x4*)(rowp + bj * 128) = w; } }
    }
};
struct EpiRes {
    static constexpr bool PERM = true, AFTER_DRAIN = false;
    bf16_t* X; const float* gate; const float* Xsrc;
    __device__ __forceinline__ void operator()(const pg8::f32x4 (&acc)[2][2][4][2], const pg8::Unit& u, int wr, int wc, int fr, int fq) const {
        const int row0 = u.pm * 256 + wr * 64 + fr, col0 = u.pn * 256 + wc * 32 + 8 * fq;
#pragma unroll
        for (int ai = 0; ai < 2; ++ai)
#pragma unroll
            for (int m = 0; m < 4; ++m) { const int row = row0 + ai * 128 + m * 16; bf16_t* rowp = X + (size_t)row * D_ + col0; const float* gp = gate + (size_t)row_vec(row) * D6 + col0;
#pragma unroll
                for (int bj = 0; bj < 2; ++bj) { const pg8::f32x4 g0 = *(const pg8::f32x4*)(gp + bj * 128), g1 = *(const pg8::f32x4*)(gp + bj * 128 + 4); pg8::f32x4 x0, x1;
                    if (Xsrc) { const float* sp = Xsrc + (size_t)row * D_ + col0 + bj * 128; x0 = *(const pg8::f32x4*)sp; x1 = *(const pg8::f32x4*)(sp + 4); }
                    else { const pg8::u32x4 r = *(const pg8::u32x4*)(rowp + bj * 128);
                        x0 = (pg8::f32x4){__builtin_bit_cast(float, r.x << 16), __builtin_bit_cast(float, r.x & 0xffff0000u), __builtin_bit_cast(float, r.y << 16), __builtin_bit_cast(float, r.y & 0xffff0000u)};
                        x1 = (pg8::f32x4){__builtin_bit_cast(float, r.z << 16), __builtin_bit_cast(float, r.z & 0xffff0000u), __builtin_bit_cast(float, r.w << 16), __builtin_bit_cast(float, r.w & 0xffff0000u)}; }
                    const pg8::f32x4 v0 = x0 + g0 * acc[ai][bj][m][0], v1 = x1 + g1 * acc[ai][bj][m][1];
                    pg8::u32x4 w; w.x = pg8::cvt_pk_bf16(v0[0], v0[1]); w.y = pg8::cvt_pk_bf16(v0[2], v0[3]); w.z = pg8::cvt_pk_bf16(v1[0], v1[1]); w.w = pg8::cvt_pk_bf16(v1[2], v1[3]);
                    *(pg8::u32x4*)(rowp + bj * 128) = w; } }
    }
};
struct EpiPart {
    static constexpr bool PERM = true, AFTER_DRAIN = false;
    bf16_t* P; int kslice;
    __device__ __forceinline__ void operator()(const pg8::f32x4 (&acc)[2][2][4][2], const pg8::Unit& u, int wr, int wc, int fr, int fq) const {
        const int row0 = u.pm * 256 + wr * 64 + fr, col0 = u.pn * 256 + wc * 32 + 8 * fq; bf16_t* base = P + (size_t)(u.koff / kslice) * MCX * D_;
#pragma unroll
        for (int ai = 0; ai < 2; ++ai)
#pragma unroll
            for (int m = 0; m < 4; ++m) { bf16_t* rowp = base + (size_t)(row0 + ai * 128 + m * 16) * D_ + col0;
#pragma unroll
                for (int bj = 0; bj < 2; ++bj) { const pg8::f32x4 v0 = acc[ai][bj][m][0], v1 = acc[ai][bj][m][1];
                    pg8::u32x4 w; w.x = pg8::cvt_pk_bf16(v0[0], v0[1]); w.y = pg8::cvt_pk_bf16(v0[2], v0[3]); w.z = pg8::cvt_pk_bf16(v1[0], v1[1]); w.w = pg8::cvt_pk_bf16(v1[2], v1[3]);
                    *(pg8::u32x4*)(rowp + bj * 128) = w; } }
    }
};

struct CvtTile { const float* src; bf16_t* dst; int ldsrc, nsrc, K, k0, n0; };
__device__ __forceinline__ CvtTile cvt_tile_of(const Ctx& c, int t) {
    constexpr int T_IN = (D_ / 64) * (NPAD / 128), T_OUT = (DMIX / 64) * (D_ / 128), T_UP = (D_ / 64) * (FF2 / 128), T_DN = (FF_ / 64) * (D_ / 128), T_L = T_IN + T_OUT + T_UP + T_DN;
    const int l = t / T_L; int r = t % T_L; CvtTile q;
    if (r < T_IN) { q.src = c.w_in() + (size_t)l * D_ * DIN; q.dst = c.Wt_in() + (size_t)l * NPAD * D_; q.ldsrc = DIN; q.nsrc = DIN; q.K = D_; q.k0 = (r / (NPAD / 128)) * 64; q.n0 = (r % (NPAD / 128)) * 128; return q; }
    r -= T_IN;
    if (r < T_OUT) { q.src = c.w_out() + (size_t)l * DMIX * D_; q.dst = c.Wt_out() + (size_t)l * D_ * DMIX; q.ldsrc = D_; q.nsrc = D_; q.K = DMIX; q.k0 = (r / (D_ / 128)) * 64; q.n0 = (r % (D_ / 128)) * 128; return q; }
    r -= T_OUT;
    if (r < T_UP) { q.src = c.w_up() + (size_t)l * D_ * FF2; q.dst = c.Wt_up() + (size_t)l * FF2 * D_; q.ldsrc = FF2; q.nsrc = FF2; q.K = D_; q.k0 = (r / (FF2 / 128)) * 64; q.n0 = (r % (FF2 / 128)) * 128; return q; }
    r -= T_UP;
    q.src = c.w_down() + (size_t)l * FF_ * D_; q.dst = c.Wt_down() + (size_t)l * D_ * FF_; q.ldsrc = D_; q.nsrc = D_; q.K = FF_; q.k0 = (r / (D_ / 128)) * 64; q.n0 = (r % (D_ / 128)) * 128; return q;
}
constexpr int CVT_T_IN = (D_ / 64) * (NPAD / 128), CVT_T_OUT = (DMIX / 64) * (D_ / 128), CVT_T_UP = (D_ / 64) * (FF2 / 128), CVT_T_DN = (FF_ / 64) * (D_ / 128);
constexpr int CVT_T_L = CVT_T_IN + CVT_T_OUT + CVT_T_UP + CVT_T_DN, CVT_T_ALL = L_ * CVT_T_L;
constexpr int CVT_B = 4;
static_assert(CVT_T_IN % CVT_B == 0 && CVT_T_OUT % CVT_B == 0 && CVT_T_UP % CVT_B == 0 && CVT_T_DN % CVT_B == 0, "conversion batches must not straddle matrices");
__device__ __forceinline__ void convert_batch(const Ctx& c, LAS float* tile, const int tid, const int t0) {
    typedef float f32x4 __attribute__((ext_vector_type(4)));
    f32x4 v[4];
#define CVT_LOAD(q) do { _Pragma("unroll") for (int i_ = 0; i_ < 4; ++i_) { const int idx_ = tid + 512 * i_, kr_ = idx_ >> 5, n_ = (q).n0 + (idx_ & 31) * 4; \
        v[i_] = n_ < (q).nsrc ? *(const f32x4*)((q).src + (size_t)((q).k0 + kr_) * (q).ldsrc + n_) : (f32x4){0.f, 0.f, 0.f, 0.f}; } } while (0)
    { const CvtTile q = cvt_tile_of(c, t0); CVT_LOAD(q); }
    for (int b = 0; b < CVT_B; ++b) {
        const CvtTile q = cvt_tile_of(c, t0 + b);
#pragma unroll
        for (int i = 0; i < 4; ++i) { const int idx = tid + 512 * i, kr = idx >> 5, n4 = (idx & 31) * 4;
#pragma unroll
            for (int j = 0; j < 4; ++j) tile[kr * 129 + n4 + j] = v[i][j]; }
        __syncthreads();
        if (b + 1 < CVT_B) { const CvtTile qn = cvt_tile_of(c, t0 + b + 1); CVT_LOAD(qn); }
#pragma unroll
        for (int i = 0; i < 2; ++i) { const int idx = tid + 512 * i, n = idx >> 3, kc = idx & 7; float x[8];
#pragma unroll
            for (int j = 0; j < 8; ++j) x[j] = tile[(kc * 8 + j) * 129 + n];
            fa::u32x4 pk; pk.x = fa::pk2(x[0], x[1]); pk.y = fa::pk2(x[2], x[3]); pk.z = fa::pk2(x[4], x[5]); pk.w = fa::pk2(x[6], x[7]);
            *(fa::u32x4*)(q.dst + (size_t)(q.n0 + n) * q.K + q.k0 + kc * 8) = pk; }
        __syncthreads();
    }
#undef CVT_LOAD
}
__device__ __forceinline__ void convert_pull(const Ctx& c, LAS float* tile, volatile LAS unsigned* misc, const int need, const int quota) {
    unsigned* ctr = c.ctl() + 8192 + 64 * 40;
    for (int n = 0;; ++n) {
        int tid_ = threadIdx.x; asm volatile("" : "+v"(tid_));
        if (tid_ == 0) { unsigned idx = 0xffffffffu; const unsigned cur = __hip_atomic_load(ctr, __ATOMIC_RELAXED, __HIP_MEMORY_SCOPE_AGENT);
            if (cur < (unsigned)CVT_T_ALL && (n < quota || cur < (unsigned)need)) idx = __hip_atomic_fetch_add(ctr, (unsigned)CVT_B, __ATOMIC_RELAXED, __HIP_MEMORY_SCOPE_AGENT);
            misc[5] = idx; }
        __syncthreads();
        const unsigned t = (unsigned)__builtin_amdgcn_readfirstlane((int)misc[5]);
        __syncthreads();
        if (t >= (unsigned)CVT_T_ALL) break;
        convert_batch(c, tile, tid_, (int)t);
    }
}

struct Args { const float* in[20]; float* out; unsigned char* ws; int ph_lo, ph_hi; };

#define IN_(k) (lo <= (k) && (k) < hi)
#define BAR_IF if (ph + 1 < hi) xcd_barrier(bar);
#define PROGRAM_HEAD
#define PH_BEGIN if (IN_(ph)) {
#define SEG(N, CALL) { Ctx c = c0; asm volatile("" : "+s"(c.ws)); unsigned t0_ = threadIdx.x; asm volatile("" : "+v"(t0_)); for (long i = (long)blockIdx.x * 512 + t0_; i < (long)(N); i += gsz) { CALL; } }
#define PH_END BAR_IF } ++ph;
#define DIFF_ATTN(l, co) { const int nu_ = fa::N_DIFF_LAT + ((co) ? fa::N_DIFF_CTX : 0); for (int u_ = blockIdx.x; u_ < nu_; u_ += gridDim.x) fa::diff_unit(c, l, ldsp, u_); }
#define DIFF_POST(l)
#define WAVES(N, CALL) { Ctx c = c0; asm volatile("" : "+s"(c.ws)); int tid_ = threadIdx.x; asm volatile("" : "+v"(tid_)); const int lane_ = tid_ & 63; \
    for (long wi_ = (long)blockIdx.x * 8 + __builtin_amdgcn_readfirstlane(tid_ >> 6); wi_ < (long)(N); wi_ += (long)gridDim.x * 8) { CALL; } }
#define QUEUE(QIDX, N, CALL) { unsigned* qc_ = c.ctl() + 8192 + 64 * (QIDX); \
    for (;;) { int tid_ = threadIdx.x; asm volatile("" : "+v"(tid_)); if (tid_ == 0) misc[4] = __hip_atomic_fetch_add(qc_, 1u, __ATOMIC_RELAXED, __HIP_MEMORY_SCOPE_AGENT); __syncthreads(); \
        const int u_ = __builtin_amdgcn_readfirstlane((int)misc[4]); __syncthreads(); if (u_ >= (N)) break; CALL; } }
#define M2_PHASE(l, co) { const int nH_ = ch::N_HG_STREAMS, nS_ = nH_ + ch::N_ML_STREAMS, nD_ = fa::N_DIFF_LAT + ((co) ? fa::N_DIFF_CTX : 0), nN_ = fa::N_NA_LAT + ((co) ? fa::N_NA_CTX : 0); \
    QUEUE(2 * (l), nS_ + nD_ + nN_ + ch::N_CH2_UNITS, { if (u_ < nH_) ch::hgrn_stream_unit(c, ldsp, tid_, u_); else if (u_ < nS_) ch::mlstm_stream_unit(c, l, ldsp, tid_, u_ - nH_); else if (u_ < nS_ + nD_) fa::diff_unit(c, l, ldsp, u_ - nS_); \
        else if (u_ < nS_ + nD_ + nN_) fa::na_unit(c, l, ldsp, u_ - nS_ - nD_); else ch::hgrn_out2_unit(c, l, ldsp, tid_, u_ - nS_ - nD_ - nN_); }) \
    if ((l) + 1 < L_) { constexpr int NCK_ = KPARTS * (D6 / 4) / 512; QUEUE(24 + (l), NCK_, { thin::modp4<0>(c, ((l) + 1) * (long)(KPARTS * (D6 / 4)) + (long)u_ * 512 + tid_); }) } }
#define UNITS(N, CALL) { int tid_ = threadIdx.x; asm volatile("" : "+v"(tid_)); for (int u_ = blockIdx.x; u_ < (N); u_ += gridDim.x) { CALL; } }
#define ML_LOCAL UNITS(ch::N_CH_UNITS, ch::local_state_unit<1>(c, ldsp, tid_, u_))
#define HG_LOCAL UNITS(ch::N_CH_UNITS, ch::local_state_unit<0>(c, ldsp, tid_, u_))
#define ML_QK
#define HG_SCORE
#define ML_OUT
#define NA_S1(l)
#define NA_S2(l, co) { const int nu_ = fa::N_NA_LAT + ((co) ? fa::N_NA_CTX : 0); for (int u_ = blockIdx.x; u_ < nu_; u_ += gridDim.x) fa::na_unit(c, l, ldsp, u_); }
#define NA_S3(l)
#define CONVERT_WEIGHTS convert_pull(c, (LAS float*)ldsp, misc, CVT_T_IN, 0);
#define CVT_NEED(need) convert_pull(c, (LAS float*)ldsp, misc, need, 0);
#define CVT_SPARE(rem, quota) if ((int)blockIdx.x >= (rem)) convert_pull(c, (LAS float*)ldsp, misc, 0, quota);
#define GEMM_IN(l) if (IN_(ph)) { pg8::Gemm g{c.Hb(), c.Wt_in() + (size_t)(l) * NPAD * D_, MT, NPAD, D_, D_}; pg8::StaticOrder S; S.init(MT, NPAD, (int)gridDim.x, (int)blockIdx.x); \
    EpiP E{c.Pb(), c.G()}; pg8::gemm_phase<EpiP, pg8::StaticOrder>(ldsp, g, S, E, nullptr); CVT_SPARE(S.nwg % (int)gridDim.x, 3) BAR_IF } ++ph;
#define GEMM_RES(Aptr, Wptr, mr, KK_, goff, S_, XS_) if (IN_(ph)) { const int G_ = (int)gridDim.x; \
    { pg8::Gemm g{Aptr, Wptr, MX, D_, KK_, KK_}; pg8::StaticOrder S; S.init(MX, D_, G_, (int)blockIdx.x); \
      EpiRes E{c.XB(), c.MOD() + (size_t)(l) * NV * D6 + (goff), XS_}; pg8::gemm_phase<EpiRes, pg8::StaticOrder>(ldsp, g, S, E, nullptr); } \
    if ((mr) > MX) { pg8::Gemm g{(Aptr) + (size_t)MX * (KK_), Wptr, MCX, D_, (KK_) / (S_), KK_}; pg8::TailOrder S; S.init(MCX, D_, G_, (int)blockIdx.x, S_, (KK_) / (S_)); \
      EpiPart E{(bf16_t*)c.PARTS(), (KK_) / (S_)}; pg8::gemm_phase<EpiPart, pg8::TailOrder>(ldsp, g, S, E, nullptr); CVT_SPARE(32 * (S_), 3) } \
    BAR_IF } ++ph;
#define GEMM_OUT(l, mr) GEMM_RES(c.Y(), c.Wt_out() + (size_t)(l) * D_ * DMIX, mr, DMIX, 2 * D_, 8, ((l) == 0 ? c.x_in() : (const float*)nullptr))
#define GEMM_UP(l, mr) if (IN_(ph)) { pg8::Gemm g{c.Hb(), c.Wt_up() + (size_t)(l) * FF2 * D_, mr, FF2, D_, D_}; pg8::StaticOrder S; S.init(mr, FF2, (int)gridDim.x, (int)blockIdx.x); \
    EpiU E{c.U()}; pg8::gemm_phase<EpiU, pg8::StaticOrder>(ldsp, g, S, E, nullptr); CVT_SPARE(S.nwg % (int)gridDim.x, 3) BAR_IF } ++ph;
#define GEMM_DOWN(l, mr) GEMM_RES(c.ACT(), c.Wt_down() + (size_t)(l) * D_ * FF_, mr, FF_, 5 * D_, 4, (const float*)nullptr)

__global__ void __launch_bounds__(512, 2) mega(Args a) {
    extern __shared__ __attribute__((aligned(16))) unsigned char lds[];
    PG8_LAS unsigned char* ldsp = (PG8_LAS unsigned char*)lds;
    Ctx c0; c0.ws = a.ws;
    const Ctx& c = c0;
    volatile LAS unsigned* misc = (volatile LAS unsigned*)(ldsp + MISC_OFF);
    if (threadIdx.x < 4) misc[threadIdx.x] = 0u;
    __syncthreads();
    const int lo = a.ph_lo, hi = a.ph_hi;
    XcdBarrier bar; bar.bar = c.ctl() + CW_BAR; bar.x = 0; bar.st = misc;
    if (hi - lo > 1) bar = xcd_barrier_post(c.ctl() + CW_BAR, misc);
    const long gsz = (long)gridDim.x * 512;
    int ph = 0;
constexpr int NPH_GPU = 2 + L_ * 10 + 1;
{
    PH_BEGIN SEG(N_P0, st_prologue(c, i)) SEG((long)KPARTS * (D6 / 4), thin::modp4<1>(c, i)) CONVERT_WEIGHTS PH_END
    PH_BEGIN SEG((long)NV * D6, st_modr(c, i)) PH_END
    for (int l = 0; l < L_; ++l) {
        const int ctx_out = l < L_ - 1; const int mrows = ctx_out ? MT : MX;
        PH_BEGIN WAVES(MX / 4, thin::mod_row<4>(c, l, 0, 4 * (int)wi_, lane_, 0, c.MOD())) WAVES(2 * MCX, if ((wi_ & 7) < 4) thin::mod_row<1>(c, l, 0, MX + (int)((wi_ >> 3) * 4 + (wi_ & 7)), lane_, l > 0 ? 4 : 0, c.MOD() + ((size_t)(l > 0 ? l - 1 : 0) * NV + B_) * D6 + 5 * D_)) CVT_NEED(l * CVT_T_L + CVT_T_IN) PH_END
        GEMM_IN(l)
        PH_BEGIN SEG(2L * NCH * 512, thin::hgrn_decay_scan(c, l, i)) WAVES(2L * NCH * 4, thin::mlstm_gates(c, l, wi_, lane_)) SEG((long)MT * 32, thin::rope16(c, i)) PH_END
        PH_BEGIN M2_PHASE(l, ctx_out) PH_END
        PH_BEGIN SEG((long)MT * 64, thin::post8(c, l, i)) CVT_NEED(l * CVT_T_L + CVT_T_IN + CVT_T_OUT) PH_END
        GEMM_OUT(l, mrows)
        PH_BEGIN WAVES(MX / 4, thin::mod_row<4>(c, l, 1, 4 * (int)wi_, lane_, 0, c.MOD())) WAVES(2 * MCX, if ((wi_ & 7) < 4) thin::mod_row<1>(c, l, 1, MX + (int)((wi_ >> 3) * 4 + (wi_ & 7)), lane_, ctx_out ? 8 : 0, c.MOD() + ((size_t)l * NV + B_) * D6 + 2 * D_)) CVT_NEED(l * CVT_T_L + CVT_T_IN + CVT_T_OUT + CVT_T_UP) PH_END
        GEMM_UP(l, mrows)
        PH_BEGIN SEG((long)thin::CONV_STRIPS * thin::CONV_J8, thin::conv_strip(c, l, i, mrows)) if (l + 1 < L_) SEG((long)NV * D6, st_modr(c, (long)(l + 1) * NV * D6 + i)) CVT_NEED((l + 1) * CVT_T_L) PH_END
        GEMM_DOWN(l, mrows)
    }
    PH_BEGIN WAVES(MX / 4, thin::final_row(c, (int)wi_, lane_)) PH_END
}
}

extern "C" void kernel_launch(void* const* d_in, const int* in_sizes, int n_in, void* d_out, int out_size, void* d_ws, size_t ws_size, hipStream_t stream) {
    static int grid = 0;
    if (grid == 0) {
        const size_t need = WS_TOTAL;
        if (n_in != 20 || out_size != MX * D_ || ws_size < need) { fprintf(stderr, "kernel_launch: unexpected shapes (n_in %d, out %d, ws %zu, need %zu)\n", n_in, out_size, ws_size, need); grid = -1; return; }
        int dev = 0, cus = 0, per_cu = 0;
        if (hipGetDevice(&dev) != hipSuccess || hipDeviceGetAttribute(&cus, hipDeviceAttributeMultiprocessorCount, dev) != hipSuccess) { grid = -1; return; }
        if (hipFuncSetAttribute((const void*)mega, hipFuncAttributeMaxDynamicSharedMemorySize, LDS_BYTES) != hipSuccess) { fprintf(stderr, "kernel_launch: hipFuncSetAttribute failed\n"); grid = -1; return; }
        if (hipOccupancyMaxActiveBlocksPerMultiprocessor(&per_cu, (const void*)mega, 512, LDS_BYTES) != hipSuccess || per_cu < 1) fprintf(stderr, "kernel_launch: occupancy query says %d\n", per_cu);
        (void)hipGetLastError();
        grid = cus;
    }
    if (grid < 0) return;
    (void)hipMemsetAsync(d_ws, 0, (size_t)(1 << 16) * sizeof(unsigned), stream);
    Args a{};
    for (int i = 0; i < 20; ++i) a.in[i] = (const float*)d_in[i];
    a.out = (float*)d_out; a.ws = (unsigned char*)d_ws;
#if ONE_LAUNCH
    a.ph_lo = 0; a.ph_hi = 2 + L_ * 10 + 1;
    hipLaunchKernelGGL(mega, dim3(grid), dim3(512), LDS_BYTES, stream, a);
#else
    for (int p = 0; p < 2 + L_ * 10 + 1; ++p) { a.ph_lo = p; a.ph_hi = p + 1; hipLaunchKernelGGL(mega, dim3(grid), dim3(512), LDS_BYTES, stream, a); }
#endif
}
```

```cpp
#include <hip/hip_runtime.h>
#include <cstdio>
#include <cstdint>
#include <cstddef>
#define DEV __device__ __forceinline__
#define HD __host__ __device__
#define MDEV __device__ __forceinline__
#ifndef ONE_LAUNCH
#define ONE_LAUNCH 1
#endif
#define XB_TMO      128
#define XB_XCNT(j)  (256  + 64 * (j))
#define XB_XSUB(j)  (1280 + 64 * (j))
#define XB_XGEN(j)  (2304 + 64 * (j))
#define XB_TOP      3328
#define XB_TOPGEN   3392
#define XCD_BAR_WORDS 3456
#define XB_SPIN_CAP (1u << 18)
#define LAS __attribute__((address_space(3)))

__device__ __forceinline__ unsigned xb_ld(unsigned* p)              { return __hip_atomic_load(p, __ATOMIC_RELAXED, __HIP_MEMORY_SCOPE_AGENT); }
__device__ __forceinline__ unsigned xb_add(unsigned* p, unsigned v) { return __hip_atomic_fetch_add(p, v, __ATOMIC_RELAXED, __HIP_MEMORY_SCOPE_AGENT); }
__device__ __forceinline__ unsigned xb_xcc_id() { return (unsigned)__builtin_amdgcn_s_getreg((3 << 11) | 20) & 0xFu; }
#define XB_SPIN(cond, bar) do { unsigned _sp = 0; while (cond) { __builtin_amdgcn_s_sleep(1); \
    if ((++_sp & 255u) == 0u) { if (xb_ld(&(bar)[XB_TMO])) break; if (_sp > XB_SPIN_CAP) { atomicAdd(&(bar)[XB_TMO], 1u); break; } } } } while (0)

struct XcdBarrier {
    unsigned* bar; unsigned x;
    volatile LAS unsigned* st;
};

__device__ __forceinline__ XcdBarrier xcd_barrier_post(unsigned* bar, volatile LAS unsigned* st) {
    XcdBarrier b; b.bar = bar; b.x = xb_xcc_id(); b.st = st;
    if (threadIdx.x == 0) (void)xb_add(&bar[XB_XCNT(b.x)], 1u);
    return b;
}
__device__ __forceinline__ void xcd_barrier_complete(unsigned* bar, unsigned x, unsigned& nloc, unsigned& nx) {
    const unsigned G = gridDim.x * gridDim.y * gridDim.z;
    unsigned sum, cnt, mine, sp = 0u;
    for (;;) {
        sum = 0u; cnt = 0u; mine = 0u;
#pragma unroll
        for (unsigned j = 0; j < 16; ++j) { const unsigned c = xb_ld(&bar[XB_XCNT(j)]); sum += c; cnt += (c > 0u) ? 1u : 0u; mine = (j == x) ? c : mine; }
        if (sum == G) break;
        __builtin_amdgcn_s_sleep(1);
        if ((++sp & 255u) == 0u) { if (xb_ld(&bar[XB_TMO])) break; if (sp > XB_SPIN_CAP) { atomicAdd(&bar[XB_TMO], 1u); break; } }
    }
    nloc = mine > 0u ? mine : 1u; nx = cnt > 0u ? cnt : 1u;
}

__device__ __forceinline__ void xcd_barrier(const XcdBarrier& b) {
    asm volatile("s_waitcnt vmcnt(0)" ::: "memory");
    __syncthreads();
    if (threadIdx.x == 0) {
        unsigned* bar = b.bar;
        __builtin_amdgcn_s_waitcnt(0);
        unsigned nloc = b.st[0], nx = b.st[1];
        if (nloc == 0u) { xcd_barrier_complete(bar, b.x, nloc, nx); b.st[0] = nloc; b.st[1] = nx; }
        const unsigned old = xb_add(&bar[XB_XSUB(b.x)], 1u);
        const unsigned gen = old / nloc;
        if (old + 1u == (gen + 1u) * nloc) {
            __builtin_amdgcn_fence(__ATOMIC_RELEASE, "agent");
            asm volatile("s_waitcnt vmcnt(0)" ::: "memory");
            const unsigned og = xb_add(&bar[XB_TOP], 1u);
            const unsigned tg = og / nx;
            if (og + 1u == (tg + 1u) * nx) xb_add(&bar[XB_TOPGEN], 1u);
            else XB_SPIN(xb_ld(&bar[XB_TOPGEN]) == tg, bar);
            __builtin_amdgcn_fence(__ATOMIC_ACQUIRE, "agent");
            xb_add(&bar[XB_XGEN(b.x)], 1u);
            asm volatile("s_waitcnt vmcnt(0)" ::: "memory");
        } else {
            XB_SPIN(xb_ld(&bar[XB_XGEN(b.x)]) == gen, bar);
            __builtin_amdgcn_fence(__ATOMIC_ACQUIRE, "agent");
            asm volatile("s_waitcnt vmcnt(0)" ::: "memory");
        }
    }
    __syncthreads();
}
namespace pg8 {
#define PG8_LAS __attribute__((address_space(3)))
typedef unsigned short bf16_t;
typedef short bf16x8 __attribute__((ext_vector_type(8)));
typedef float f32x4 __attribute__((ext_vector_type(4)));
typedef unsigned u32x4 __attribute__((ext_vector_type(4)));
constexpr int BM = 256, BK = 64, HALF = 128, HTB = HALF * BK * 2  , STAGE_BYTES = 8 * HTB, NXCD = 8, WGM = 8;

__host__ __device__ __forceinline__ int lds_byte(int r, int c) { const int st = (r >> 4) * 2 + (c >> 5), rr = r & 15, cc = c & 31, ob = rr * 64 + cc * 2; return st * 1024 + (ob ^ (((ob >> 9) & 1) << 5)); }
__host__ __device__ __forceinline__ void stage_rc(int b, int& R, int& C) { const int st = b / 1024, sb = b % 1024, swz = sb ^ (((sb >> 9) & 1) << 5); R = (st >> 1) * 16 + swz / 64; C = (st & 1) * 32 + (swz % 64) / 2; }
__host__ __device__ __forceinline__ int perm32(int rho) { const int n = rho >> 4, i = rho & 15; return 8 * (i >> 2) + 4 * n + (i & 3); }

struct Unit { int pm, pn, koff; };
struct Gemm { const bf16_t* A; const bf16_t* Bt; int M, N, K, ld; };

struct StaticOrder {
    int nM, nN, nwg, G, c, rounds;
    __host__ __device__ void init(int M, int N, int G_, int c_) { nM = M / BM; nN = N / BM; nwg = nM * nN; G = G_; c = c_; rounds = 1 << 30; }
    __host__ __device__ static void tile_of(int L, int nwg, int nM, int nN, Unit& u) {
        int wgid = L; { const int q = nwg / NXCD, r = nwg % NXCD, xcd = wgid % NXCD, off = wgid / NXCD; wgid = (xcd < r ? xcd * (q + 1) : r * (q + 1) + (xcd - r) * q) + off; }
        const int nig = WGM * nN, gid = wgid / nig, fm = gid * WGM, gsz = (nM - fm) < WGM ? (nM - fm) : WGM;
        u.pm = fm + ((wgid % nig) % gsz); u.pn = (wgid % nig) / gsz; u.koff = 0;
    }
    __host__ __device__ bool next(int i, Unit& u) const {
        const long L = (long)i * G + c; if (L >= nwg || i >= rounds) return false;
        tile_of((int)L, nwg, nM, nN, u); return true;
    }
    __device__ __forceinline__ void a_ready(const Unit&) const {}
    __device__ __forceinline__ void done(const Unit&) const {}
};
struct TailOrder {
    int nM, nN, nwg, G, c, L0, S, kslice;
    __host__ __device__ void init(int M, int N, int G_, int c_, int S_, int kslice_) { nM = M / BM; nN = N / BM; nwg = nM * nN; G = G_; c = c_; L0 = (nwg / G_) * G_; S = S_; kslice = kslice_; }
    __host__ __device__ bool next(int i, Unit& u) const {
        const long j = (long)i * G + c; if (j >= (long)(nwg - L0) * S) return false;
        StaticOrder::tile_of(L0 + (int)(j / S), nwg, nM, nN, u); u.koff = (int)(j % S) * kslice; return true;
    }
    __device__ __forceinline__ void a_ready(const Unit&) const {}
    __device__ __forceinline__ void done(const Unit&) const {}
};
__device__ __forceinline__ unsigned cvt_pk_bf16(float lo, float hi) { unsigned r; asm volatile("v_cvt_pk_bf16_f32 %0, %1, %2" : "=v"(r) : "v"(lo), "v"(hi)); return r; }
template <class Epi, class Sched, bool STAMP = false>
__device__ __forceinline__ void gemm_phase(PG8_LAS unsigned char* lds, const Gemm g, const Sched& S, const Epi& E, unsigned long long* stamps) {
    int tid_ = threadIdx.x; asm volatile("" : "+v"(tid_));
    const int tid = tid_, wid = __builtin_amdgcn_readfirstlane(tid >> 6), lane = tid & 63, wr = wid >> 2, wc = wid & 3, fr = lane & 15, fq = lane >> 4;
    const int K = g.ld, nt = g.K / BK;
    unsigned voffA[2], voffB[2];
#pragma unroll
    for (int i = 0; i < 2; ++i) { int R, C; stage_rc(tid * 16 + i * 8192, R, C); const int Rb = Epi::PERM ? ((R & ~31) + perm32(R & 31)) : R;
        voffA[i] = (unsigned)(R * K + C) * 2u; voffB[i] = (unsigned)(Rb * K + C) * 2u; }
    const size_t kstep = (size_t)(BK * 2);
    const size_t hstep = (size_t)HALF * K * 2;
    const size_t tstep = 2 * hstep;
    const unsigned ldsw = (unsigned)wid * 1024u;
    const int aoff = lds_byte(wr * 64 + fr, fq * 8), boff = lds_byte(wc * 32 + fr, fq * 8);
#define PG8_SA(b, h) (((b) * 2 + (h)) * HTB)
#define PG8_SB(b, h) ((4 + (b) * 2 + (h)) * HTB)
#define PG8_STAGE(bufoff, gbase, voff) do { _Pragma("unroll") for (int _i = 0; _i < 2; ++_i) \
        __builtin_amdgcn_global_load_lds((const unsigned*)((const char*)(gbase) + (voff)[_i]), (PG8_LAS unsigned*)(lds + (bufoff) + ldsw + _i * 8192), 16, 0, 0); } while (0)
#define PG8_LDA(dst, b, h) do { _Pragma("unroll") for (int m = 0; m < 4; ++m) _Pragma("unroll") for (int k = 0; k < 2; ++k) dst[m][k] = *(const PG8_LAS bf16x8*)(lds + PG8_SA(b, h) + aoff + m * 2048 + k * 1024); } while (0)
#define PG8_LDB(dst, b, h) do { _Pragma("unroll") for (int n = 0; n < 2; ++n) _Pragma("unroll") for (int k = 0; k < 2; ++k) dst[n][k] = *(const PG8_LAS bf16x8*)(lds + PG8_SB(b, h) + boff + n * 2048 + k * 1024); } while (0)
#define PG8_MMA(ai, bj, At, Bt) do { __builtin_amdgcn_s_setprio(1); _Pragma("unroll") for (int m = 0; m < 4; ++m) _Pragma("unroll") for (int n = 0; n < 2; ++n) _Pragma("unroll") for (int k = 0; k < 2; ++k) \
        acc[ai][bj][m][n] = __builtin_amdgcn_mfma_f32_16x16x32_bf16(Bt[n][k], At[m][k], acc[ai][bj][m][n], 0, 0, 0); __builtin_amdgcn_s_setprio(0); } while (0)
#define PG8_WAIT_V(n) asm volatile("s_waitcnt vmcnt(" #n ")" ::: "memory")
#define PG8_WAIT_L(n) asm volatile("s_waitcnt lgkmcnt(" #n ")" ::: "memory")
#define PG8_BAR __builtin_amdgcn_s_barrier()
#define PG8_SCHED __builtin_amdgcn_sched_barrier(0)
    Unit cur, nxt; int ui = 0;
    if (!S.next(0, cur)) return;
    f32x4 acc[2][2][4][2];
#pragma unroll
    for (int a = 0; a < 2; ++a)
#pragma unroll
        for (int b = 0; b < 2; ++b)
#pragma unroll
            for (int m = 0; m < 4; ++m)
#pragma unroll
                for (int n = 0; n < 2; ++n) acc[a][b][m][n] = (f32x4){0.f, 0.f, 0.f, 0.f};
    bf16x8 At[4][2], B0[2][2], B1[2][2];
    const char* cA = (const char*)g.A + (size_t)cur.pm * tstep + (size_t)cur.koff * 2; const char* cB = (const char*)g.Bt + (size_t)cur.pn * tstep + (size_t)cur.koff * 2;
    S.a_ready(cur);
    PG8_STAGE(PG8_SB(0, 0), cB, voffB); PG8_STAGE(PG8_SA(0, 0), cA, voffA); PG8_STAGE(PG8_SB(0, 1), cB + hstep, voffB); PG8_STAGE(PG8_SA(0, 1), cA + hstep, voffA);
    if (wr == 1) PG8_BAR;
    PG8_WAIT_V(4); PG8_BAR;
    PG8_STAGE(PG8_SB(1, 0), cB + kstep, voffB); PG8_STAGE(PG8_SA(1, 0), cA + kstep, voffA); PG8_STAGE(PG8_SB(1, 1), cB + hstep + kstep, voffB);
    PG8_WAIT_V(6); PG8_BAR;
    for (;;) {
        const bool has_next = S.next(ui + 1, nxt);
        const char* nA = has_next ? (const char*)g.A + (size_t)nxt.pm * tstep + (size_t)nxt.koff * 2 : cA; const char* nB = has_next ? (const char*)g.Bt + (size_t)nxt.pn * tstep + (size_t)nxt.koff * 2 : cB;
        for (int t = 0; t < nt; t += 2) {
            const bool last = (t == nt - 2);
            const char* a1 = cA + (size_t)(t + 1) * kstep;
            const char* a2 = last ? nA : cA + (size_t)(t + 2) * kstep; const char* b2 = last ? nB : cB + (size_t)(t + 2) * kstep;
            const char* a3 = a2 + kstep; const char* b3 = b2 + kstep;
            if (last && has_next) S.a_ready(nxt);
            PG8_LDB(B0, 0, 0); PG8_SCHED; PG8_LDA(At, 0, 0); PG8_STAGE(PG8_SA(1, 1), a1 + hstep, voffA);
            PG8_WAIT_L(8); PG8_BAR; PG8_WAIT_L(0); PG8_MMA(0, 0, At, B0); PG8_BAR; PG8_SCHED;
            PG8_LDB(B1, 0, 1); PG8_STAGE(PG8_SB(0, 0), b2, voffB);
            PG8_BAR; PG8_WAIT_L(0); PG8_MMA(0, 1, At, B1); PG8_BAR;
            PG8_LDA(At, 0, 1); PG8_STAGE(PG8_SA(0, 0), a2, voffA);
            PG8_BAR; PG8_WAIT_L(0); PG8_MMA(1, 0, At, B0); PG8_BAR; PG8_SCHED;
            PG8_STAGE(PG8_SB(0, 1), b2 + hstep, voffB);
            PG8_WAIT_V(6); PG8_BAR; PG8_MMA(1, 1, At, B1); PG8_BAR;
            PG8_LDB(B0, 1, 0); PG8_SCHED; PG8_LDA(At, 1, 0); PG8_STAGE(PG8_SA(0, 1), a2 + hstep, voffA);
            PG8_WAIT_L(8); PG8_BAR; PG8_WAIT_L(0); PG8_MMA(0, 0, At, B0); PG8_BAR; PG8_SCHED;
            PG8_LDB(B1, 1, 1); PG8_STAGE(PG8_SB(1, 0), b3, voffB);
            PG8_BAR; PG8_WAIT_L(0); PG8_MMA(0, 1, At, B1); PG8_BAR;
            PG8_LDA(At, 1, 1); PG8_STAGE(PG8_SA(1, 0), a3, voffA);
            PG8_BAR; PG8_WAIT_L(0); PG8_MMA(1, 0, At, B0); PG8_BAR; PG8_SCHED;
            PG8_STAGE(PG8_SB(1, 1), b3 + hstep, voffB);
            PG8_WAIT_V(6); PG8_BAR; PG8_MMA(1, 1, At, B1); PG8_BAR;
        }
        if constexpr (!Epi::AFTER_DRAIN) { E(acc, cur, wr, wc, fr, fq); S.done(cur); }
        if (!has_next) break;
#pragma unroll
        for (int a = 0; a < 2; ++a)
#pragma unroll
            for (int b = 0; b < 2; ++b)
#pragma unroll
                for (int m = 0; m < 4; ++m)
#pragma unroll
                    for (int n = 0; n < 2; ++n) acc[a][b][m][n] = (f32x4){0.f, 0.f, 0.f, 0.f};
        cur = nxt; cA = nA; cB = nB; ++ui;
    }
    PG8_WAIT_V(0);
    if (wr == 0) PG8_BAR;
    PG8_BAR;
    if constexpr (Epi::AFTER_DRAIN) { E.fused(acc, cur, wr, wc, fr, fq, lds, wid, lane); S.done(cur); }
#undef PG8_SA
#undef PG8_SB
#undef PG8_STAGE
#undef PG8_LDA
#undef PG8_LDB
#undef PG8_MMA
#undef PG8_WAIT_V
#undef PG8_WAIT_L
#undef PG8_BAR
#undef PG8_SCHED
}
}
#ifndef CFG_B
#define CFG_B 4
#define CFG_T 2048
#define CFG_TC 256
#define CFG_D 2048
#define CFG_FF 5632
#define CFG_L 4
#endif
constexpr int B_ = CFG_B, T_ = CFG_T, TC_ = CFG_TC, D_ = CFG_D, FF_ = CFG_FF, L_ = CFG_L;
constexpr int NV = B_ + 1;
constexpr int MX = B_ * T_, MCX = B_ * TC_, MT = MX + MCX;
constexpr int NCH = MT / 64, XCH = T_ / 64, CCH = TC_ / 64, NSC = XCH + CCH;
constexpr int GW = 64, ROWS = T_ / GW;
constexpr int DIN = 7696, NP = 7680, NPAD = 7936, DMIX = 2048, D6 = 6 * D_, FF2 = 2 * FF_;
constexpr int NSW = 128 + TC_;
constexpr int KPARTS = 32;
constexpr float EPS_ = 1e-6f;
constexpr int A_Q = 0, A_I = 512, A_ZF = 1024, A_G = 2048;
constexpr int B_Q = 2560, B_V = 3584;
constexpr int C_Q = 4096, C_K = 4608, C_V = 5120;
constexpr int D_Q = 5632, D_K = 6144, D_V = 6656, D_O = 7168;

typedef unsigned short bf16_t;
DEV float bf2f(bf16_t b) { unsigned u = ((unsigned)b) << 16; float f; __builtin_memcpy(&f, &u, 4); return f; }
DEV bf16_t f2bf(float f) { unsigned u; __builtin_memcpy(&u, &f, 4); u += 0x7FFFu + ((u >> 16) & 1u); return (bf16_t)(u >> 16); }
DEV float sigmoidf_(float x) { return 1.0f / (1.0f + expf(-x)); }
DEV float siluf_(float x) { return x / (1.0f + expf(-x)); }
DEV float logsigf_(float x) { return x >= 0.f ? -log1pf(expf(-x)) : x - log1pf(expf(x)); }
DEV int imin(int a, int b) { return a < b ? a : b; }
DEV int imax(int a, int b) { return a > b ? a : b; }
DEV int iclip(int v, int lo, int hi) { return v < lo ? lo : (v > hi ? hi : v); }

#ifdef HOST_TEST
#define WS_FIELDS_HOST(F) \
    F(PART, float, (size_t)MT * (D_ / 64)) \
    F(RSTD, float, MT) \
    F(HA, float, (size_t)2 * NCH * 4 * 4096) \
    F(MQK, float, (size_t)NCH * 4 * 4096) \
    F(MW, float, (size_t)2 * NCH * 4 * 4096) \
    F(MSC, float, (size_t)2 * MT * 4 * 2) \
    F(DO, float, (size_t)2 * MT * 512) \
    F(NS, float, (size_t)MT * 4 * NSW)
#else
#define WS_FIELDS_HOST(F) \
    F(PART, float, 0) \
    F(RSTD, float, 0) \
    F(HA, float, 0) \
    F(MQK, float, 0) \
    F(MW, float, 0) \
    F(MSC, float, 0) \
    F(DO, float, 0) \
    F(NS, float, 0)
#endif
#define WS_FIELDS(F) \
    F(ctl, unsigned, (size_t)1 << 16) \
    WS_FIELDS_HOST(F) \
    F(PARTS, float, (size_t)8 * MCX * D_) \
    F(ROPE, float, 64 * 16 * 2) \
    F(HSB, bf16_t, (size_t)2 * NCH * 4 * 16384) \
    F(MSB, bf16_t, (size_t)2 * NCH * 4 * 16384) \
    F(X, float, (size_t)MT * D_) \
    F(XB, bf16_t, (size_t)MT * D_) \
    F(SC, float, NV * D_) \
    F(MODP, float, (size_t)L_ * KPARTS * NV * D6) \
    F(MOD, float, (size_t)L_ * NV * D6) \
    F(LBV, float, L_ * 2 * 512) \
    F(LAMF, float, 64) \
    F(G, float, (size_t)MT * 16) \
    F(Hb, bf16_t, (size_t)MT * D_) \
    F(Pb, bf16_t, (size_t)MT * NP) \
    F(QKB, bf16_t, (size_t)MT * 1024) \
    F(Y, bf16_t, (size_t)MT * DMIX) \
    F(U, bf16_t, (size_t)MT * FF2) \
    F(ACT, bf16_t, (size_t)MT * FF_) \
    F(QH, float, (size_t)MT * 512) \
    F(KK, float, (size_t)2 * MT * 512) \
    F(BC, float, (size_t)2 * MT * 512) \
    F(BL, float, (size_t)2 * NCH * 512) \
    F(HST, float, (size_t)2 * NCH * 4 * 16384) \
    F(HO, float, (size_t)2 * MT * 512) \
    F(MB, float, (size_t)2 * MT * 4) \
    F(MWU, float, (size_t)2 * MT * 4) \
    F(MLI, float, (size_t)2 * MT * 4) \
    F(MBL, float, (size_t)2 * NCH * 4) \
    F(MML, float, (size_t)2 * NCH * 4) \
    F(MMIN, float, (size_t)2 * NCH * 4) \
    F(MCs, float, (size_t)2 * NCH * 4 * 16384) \
    F(MN, float, (size_t)2 * NCH * 4 * 128) \
    F(MH, float, (size_t)2 * MT * 512) \
    F(Wt_in, bf16_t, (size_t)L_ * NPAD * D_) \
    F(Wt_out, bf16_t, (size_t)L_ * D_ * DMIX) \
    F(Wt_up, bf16_t, (size_t)L_ * FF2 * D_) \
    F(Wt_down, bf16_t, (size_t)L_ * D_ * FF_)
enum WsId {
#define F(name, type, count) W_##name,
    WS_FIELDS(F)
#undef F
    W_COUNT };
constexpr size_t WS_BYTES[W_COUNT] = {
#define F(name, type, count) (size_t)(count) * sizeof(type),
    WS_FIELDS(F)
#undef F
};
constexpr size_t ws_off(int id) { size_t o = 0; for (int i = 0; i < id; ++i) o += (WS_BYTES[i] + 255) & ~(size_t)255; return o; }
constexpr size_t WS_TOTAL = ws_off(W_COUNT);
struct Ctx {
#ifdef HOST_TEST
    const float* in_[20]; float* out_;
    MDEV const float* inp(int i) const { return in_[i]; }
    MDEV float* out() const { return out_; }
#else
    MDEV const float* inp(int i) const { return ((const float* const __attribute__((address_space(4)))*)__builtin_amdgcn_kernarg_segment_ptr())[i]; }
    MDEV float* out() const { return (float*)inp(20); }
#endif
    MDEV const float* x_in() const { return inp(0); }
    MDEV const float* c_in() const { return inp(1); }
    MDEV const float* ctx_in() const { return inp(2); }
    MDEV const float* c_ctx() const { return inp(3); }
    MDEV const float* w_ada() const { return inp(4); }
    MDEV const float* b_ada() const { return inp(5); }
    MDEV const float* w_in() const { return inp(6); }
    MDEV const float* hgrn_lb() const { return inp(7); }
    MDEV const float* hgrn_norm_w() const { return inp(8); }
    MDEV const float* diff_lam() const { return inp(9); }
    MDEV const float* diff_norm_w() const { return inp(10); }
    MDEV const float* na_rpb() const { return inp(11); }
    MDEV const float* mlstm_f_bias() const { return inp(12); }
    MDEV const float* mlstm_norm_w() const { return inp(13); }
    MDEV const float* w_out() const { return inp(14); }
    MDEV const float* w_up() const { return inp(15); }
    MDEV const float* conv_w() const { return inp(16); }
    MDEV const float* conv_b() const { return inp(17); }
    MDEV const float* w_down() const { return inp(18); }
    MDEV const float* final_norm_w() const { return inp(19); }
    unsigned char* ws;
#define F(name, type, count) MDEV type* name() const { constexpr size_t o = ws_off(W_##name); return (type*)(ws + o); }
    WS_FIELDS(F)
#undef F
};

DEV int row_vec(int m) { return m < MX ? m / T_ : B_; }
DEV int row_batch(int m) { return m < MX ? m / T_ : (m - MX) / TC_; }
DEV int row_pos(int m) { return m < MX ? m % T_ : (m - MX) % TC_; }
DEV int row_len(int m) { return m < MX ? T_ : TC_; }
DEV int stream_chunk(int dir, int b, int i) {
    if (i < CCH) { const int cc = dir == 0 ? i : CCH - 1 - i; return (MX + b * TC_) / 64 + cc; }
    const int j = i - CCH, xc = dir == 0 ? j : XCH - 1 - j; return b * XCH + xc;
}
DEV int proc_row(int dir, int chunk, int j) { return chunk * 64 + (dir == 0 ? j : 63 - j); }
DEV int proc_idx(int dir, int m) { const int o = m & 63; return dir == 0 ? o : 63 - o; }

#ifdef HOST_TEST
constexpr long N_P0 = (long)MT * D_ + NV * D_ + L_ * 2 * 512 + L_ + 64 * 16;
#else
constexpr long N_P0 = NV * D_ + L_ * 2 * 512 + L_ + 64 * 16;
#endif
DEV void st_prologue(const Ctx& c, long i) {
#ifdef HOST_TEST
    if (i < (long)MT * D_) { c.X()[i] = i < (long)MX * D_ ? c.x_in()[i] : c.ctx_in()[i - (long)MX * D_]; return; }
    i -= (long)MT * D_;
#endif
    if (i < NV * D_) { const int v = (int)(i / D_), k = (int)(i % D_); c.SC()[i] = siluf_(v < B_ ? c.c_in()[v * D_ + k] : c.c_ctx()[k]); return; }
    i -= NV * D_;
    if (i < L_ * 2 * 512) {
        const int l = (int)(i / 1024), rc = (int)(i % 1024);
        float mx = -1e30f; for (int j = 0; j < L_; ++j) mx = fmaxf(mx, c.hgrn_lb()[j * 1024 + rc]);
        float den = 0.f, num = 0.f; for (int j = 0; j < L_; ++j) { const float e = expf(c.hgrn_lb()[j * 1024 + rc] - mx); den += e; if (j >= 1 && j <= l) num += e; }
        c.LBV()[i] = num / den; return; }
    i -= L_ * 2 * 512;
    if (i >= L_) { const int k = (int)(i - L_), pos = k >> 4, ii = k & 15; const float ang = (float)pos * powf(10000.0f, -(float)(2 * ii) / 32.0f); c.ROPE()[2 * k] = cosf(ang); c.ROPE()[2 * k + 1] = sinf(ang); return; }
    { const int l = (int)i; const float* lm = c.diff_lam() + l * 4 * 64; float s1 = 0.f, s2 = 0.f;
      for (int d = 0; d < 64; ++d) { s1 += lm[d] * lm[64 + d]; s2 += lm[128 + d] * lm[192 + d]; }
      const float li = 0.8f - 0.6f * expf(-0.3f * (float)l);
      c.LAMF()[2 * l] = expf(s1) - expf(s2) + li; c.LAMF()[2 * l + 1] = li; }
}
constexpr long N_MODP = (long)L_ * KPARTS * D6;
DEV void st_modp(const Ctx& c, long i) {
    const int col = (int)(i % D6), kp = (int)((i / D6) % KPARTS), l = (int)(i / ((long)D6 * KPARTS));
    float acc[NV];
#pragma unroll
    for (int v = 0; v < NV; ++v) acc[v] = 0.f;
    const int k0 = kp * (D_ / KPARTS);
    for (int k = k0; k < k0 + D_ / KPARTS; ++k) { const float w = c.w_ada()[((size_t)l * D_ + k) * D6 + col];
#pragma unroll
        for (int v = 0; v < NV; ++v) acc[v] += c.SC()[v * D_ + k] * w; }
#pragma unroll
    for (int v = 0; v < NV; ++v) c.MODP()[(((size_t)l * KPARTS + kp) * NV + v) * D6 + col] = acc[v];
}
constexpr long N_MODR = (long)L_ * NV * D6;
DEV void st_modr(const Ctx& c, long i) {
    const int col = (int)(i % D6), v = (int)((i / D6) % NV), l = (int)(i / ((long)D6 * NV));
    float s = c.b_ada()[(size_t)l * D6 + col];
    for (int kp = 0; kp < KPARTS; ++kp) s += c.MODP()[(((size_t)l * KPARTS + kp) * NV + v) * D6 + col];
    c.MOD()[i] = s;
}

constexpr long N_SS = (long)MT * (D_ / 64);
DEV void st_sumsq(const Ctx& c, long i) { const float* p = c.X() + i * 64; float s = 0.f; for (int k = 0; k < 64; ++k) s += p[k] * p[k]; c.PART()[i] = s; }
DEV void st_rstd(const Ctx& c, long m) { float s = 0.f; for (int k = 0; k < D_ / 64; ++k) s += c.PART()[m * (D_ / 64) + k]; c.RSTD()[m] = 1.0f / sqrtf(s / (float)D_ + EPS_); }
DEV void st_mod(const Ctx& c, int l, int which, long i) {
    const int m = (int)(i / D_), col = (int)(i % D_); const float* md = c.MOD() + ((size_t)l * NV + row_vec(m)) * D6 + which * 3 * D_;
    c.Hb()[i] = f2bf(c.X()[i] * c.RSTD()[m] * (1.0f + md[D_ + col]) + md[col]);
}

DEV void st_a1(const Ctx& c, int l, long i) {
    const int m = (int)(i / 512), col = (int)(i % 512); const bf16_t* p = c.Pb() + (size_t)m * NP;
    c.QH()[i] = siluf_(bf2f(p[A_Q + col])) * 0.08838834764831845f;
    for (int dir = 0; dir < 2; ++dir) { const float z = bf2f(p[A_ZF + dir * 512 + col]), lb = c.LBV()[(l * 2 + dir) * 512 + col];
        const float kk = (1.0f - lb) * sigmoidf_(-z);
        c.KK()[((size_t)dir * MT + m) * 512 + col] = kk; c.BC()[((size_t)dir * MT + m) * 512 + col] = log1pf(-kk); }
}
DEV void st_a2(const Ctx& c, long i) {
    const int col = (int)(i % 512), chunk = (int)((i / 512) % NCH), dir = (int)(i / (512L * NCH)); float s = 0.f;
    for (int j = 0; j < 64; ++j) { float* p = c.BC() + ((size_t)dir * MT + proc_row(dir, chunk, j)) * 512 + col; s += *p; *p = s; }
    c.BL()[((size_t)dir * NCH + chunk) * 512 + col] = s;
}
DEV void st_a3(const Ctx& c, long i) {
    const int e = (int)(i & 127), d = (int)((i >> 7) & 127), h = (int)((i >> 14) & 3), chunk = (int)((i >> 16) % NCH), dir = (int)((i >> 16) / NCH);
    const float bl = c.BL()[((size_t)dir * NCH + chunk) * 512 + h * 128 + d]; float s = 0.f;
    for (int j = 0; j < 64; ++j) { const int m = chunk * 64 + j; const size_t o = ((size_t)dir * MT + m) * 512 + h * 128 + d;
        s += c.KK()[o] * expf(bl - c.BC()[o]) * bf2f(c.Pb()[(size_t)m * NP + A_I + h * 128 + e]); }
    c.HST()[i] = s;
}
DEV void st_a4(const Ctx& c, long i) {
    const int e = (int)(i & 127), d = (int)((i >> 7) & 127), h = (int)((i >> 14) & 3), b = (int)((i >> 16) % B_), dir = (int)((i >> 16) / B_);
    float S = 0.f;
    for (int s = 0; s < NSC; ++s) { const int chunk = stream_chunk(dir, b, s); float* p = c.HST() + (((size_t)dir * NCH + chunk) * 4 + h) * 16384 + d * 128 + e;
        const float t = *p; *p = S; S = expf(c.BL()[((size_t)dir * NCH + chunk) * 512 + h * 128 + d]) * S + t; }
}
DEV void st_a5(const Ctx& c, long i) {
    const int s = (int)(i & 63), t = (int)((i >> 6) & 63), h = (int)((i >> 12) & 3), chunk = (int)((i >> 14) % NCH), dir = (int)((i >> 14) / NCH);
    float a = 0.f;
    if (s <= t) { const size_t ot = ((size_t)dir * MT + proc_row(dir, chunk, t)) * 512 + h * 128, os = ((size_t)dir * MT + proc_row(dir, chunk, s)) * 512 + h * 128;
        const float* q = c.QH() + (size_t)proc_row(dir, chunk, t) * 512 + h * 128;
        for (int d = 0; d < 128; ++d) a += q[d] * c.KK()[os + d] * expf(c.BC()[ot + d] - c.BC()[os + d]); }
    c.HA()[i] = a;
}
DEV void st_a6(const Ctx& c, long i) {
    const int col = (int)(i % 512), m = (int)((i / 512) % MT), dir = (int)(i / (512L * MT)), h = col >> 7, e = col & 127, chunk = m >> 6, t = proc_idx(dir, m);
    const float* S = c.HST() + (((size_t)dir * NCH + chunk) * 4 + h) * 16384; const float* q = c.QH() + (size_t)m * 512 + h * 128; const float* bc = c.BC() + ((size_t)dir * MT + m) * 512 + h * 128;
    float o = 0.f;
    for (int d = 0; d < 128; ++d) o += q[d] * expf(bc[d]) * S[d * 128 + e];
    const float* A = c.HA() + ((((size_t)dir * NCH + chunk) * 4 + h) * 64 + t) * 64;
    for (int s = 0; s <= t; ++s) o += A[s] * bf2f(c.Pb()[(size_t)proc_row(dir, chunk, s) * NP + A_I + col]);
    c.HO()[i] = o;
}
DEV void st_a7(const Ctx& c, int l, long i) {
    const int h = (int)(i & 3), m = (int)(i >> 2); const float* o0 = c.HO() + (size_t)m * 512 + h * 128; const float* o1 = o0 + (size_t)MT * 512;
    float ss = 0.f; for (int e = 0; e < 128; ++e) { const float o = o0[e] + o1[e]; ss += o * o; }
    const float r = 1.0f / sqrtf(ss / 128.f + EPS_);
    for (int e = 0; e < 128; ++e) c.Y()[(size_t)m * DMIX + h * 128 + e] = f2bf((o0[e] + o1[e]) * r * c.hgrn_norm_w()[l * 512 + h * 128 + e] * siluf_(bf2f(c.Pb()[(size_t)m * NP + A_G + h * 128 + e])));
}

DEV void st_d2(const Ctx& c, int l, long i) {
    const int h = (int)(i & 3), chunk = (int)((i >> 2) % NCH), dir = (int)((i >> 2) / NCH); const float fb = c.mlstm_f_bias()[(l * 2 + dir) * 4 + h];
    float s = 0.f;
    for (int j = 0; j < 64; ++j) { const int m = proc_row(dir, chunk, j); const float* g = c.G() + (size_t)m * 16;
        s += logsigf_(g[(2 * dir + 1) * 4 + h] + fb); c.MB()[((size_t)dir * MT + m) * 4 + h] = s; c.MLI()[((size_t)dir * MT + m) * 4 + h] = g[(2 * dir) * 4 + h]; }
    float mx = -1e30f;
    for (int j = 0; j < 64; ++j) { const size_t o = ((size_t)dir * MT + chunk * 64 + j) * 4 + h; mx = fmaxf(mx, s - c.MB()[o] + c.MLI()[o]); }
    for (int j = 0; j < 64; ++j) { const size_t o = ((size_t)dir * MT + chunk * 64 + j) * 4 + h; c.MWU()[o] = expf(s - c.MB()[o] + c.MLI()[o] - mx); }
    c.MBL()[((size_t)dir * NCH + chunk) * 4 + h] = s; c.MML()[((size_t)dir * NCH + chunk) * 4 + h] = mx;
}
DEV void st_d3(const Ctx& c, long i) {
    const int e = (int)(i & 127), d = (int)((i >> 7) & 127), h = (int)((i >> 14) & 3), chunk = (int)((i >> 16) % NCH), dir = (int)((i >> 16) / NCH);
    float s = 0.f, sn = 0.f;
    for (int j = 0; j < 64; ++j) { const int m = chunk * 64 + j; const bf16_t* p = c.Pb() + (size_t)m * NP; const float wk = c.MWU()[((size_t)dir * MT + m) * 4 + h] * bf2f(p[D_K + h * 128 + d]);
        s += wk * bf2f(p[D_V + h * 128 + e]); sn += wk; }
    c.MCs()[i] = s; if (e == 0) c.MN()[(((size_t)dir * NCH + chunk) * 4 + h) * 128 + d] = sn;
}
DEV void st_d4(const Ctx& c, long i) {
    const int e = (int)(i & 127), d = (int)((i >> 7) & 127), h = (int)((i >> 14) & 3), b = (int)((i >> 16) % B_), dir = (int)((i >> 16) / B_);
    float C = 0.f, n = 0.f, mm = 0.f;
    for (int s = 0; s < NSC; ++s) { const int chunk = stream_chunk(dir, b, s); const size_t oc = ((size_t)dir * NCH + chunk) * 4 + h;
        const float bl = c.MBL()[oc], ml = c.MML()[oc], mn = fmaxf(bl + mm, ml), ws = expf(bl + mm - mn), wl = expf(ml - mn);
        float* p = c.MCs() + oc * 16384 + d * 128 + e; const float t = *p; *p = C; C = ws * C + wl * t;
        if (e == 0) { float* pn = c.MN() + oc * 128 + d; const float tn = *pn; *pn = n; n = ws * n + wl * tn; if (d == 0) c.MMIN()[oc] = mm; }
        mm = mn; }
}
DEV void st_d5(const Ctx& c, long i) {
    const int s = (int)(i & 63), t = (int)((i >> 6) & 63), h = (int)((i >> 12) & 3), chunk = (int)(i >> 14);
    const bf16_t* q = c.Pb() + (size_t)(chunk * 64 + t) * NP + D_Q + h * 128; const bf16_t* k = c.Pb() + (size_t)(chunk * 64 + s) * NP + D_K + h * 128;
    float a = 0.f; for (int d = 0; d < 128; ++d) a += bf2f(q[d]) * bf2f(k[d]);
    c.MQK()[i] = a * 0.08838834764831845f;
}
DEV void st_d6(const Ctx& c, long i) {
    const int h = (int)(i & 3), m = (int)((i >> 2) % MT), dir = (int)((i >> 2) / MT), chunk = m >> 6, t = proc_idx(dir, m);
    const size_t oc = ((size_t)dir * NCH + chunk) * 4 + h; const float bt = c.MB()[((size_t)dir * MT + m) * 4 + h], inter = bt + c.MMIN()[oc];
    float mt = inter;
    for (int s = 0; s <= t; ++s) { const size_t o = ((size_t)dir * MT + proc_row(dir, chunk, s)) * 4 + h; mt = fmaxf(mt, bt - c.MB()[o] + c.MLI()[o]); }
    const float wi = expf(inter - mt);
    float* W = c.MW() + (oc * 64 + t) * 64; float sw = 0.f;
    for (int s = 0; s < 64; ++s) { float w = 0.f;
        if (s <= t) { const int ms = proc_row(dir, chunk, s); const size_t o = ((size_t)dir * MT + ms) * 4 + h;
            w = expf(bt - c.MB()[o] + c.MLI()[o] - mt) * c.MQK()[(((size_t)chunk * 4 + h) * 64 + (m & 63)) * 64 + (ms & 63)]; }
        W[s] = w; sw += w; }
    const bf16_t* q = c.Pb() + (size_t)m * NP + D_Q + h * 128; const float* nin = c.MN() + oc * 128; float qn = 0.f;
    for (int d = 0; d < 128; ++d) qn += bf2f(q[d]) * nin[d];
    const float den = wi * qn * 0.08838834764831845f + sw;
    c.MSC()[(((size_t)dir * MT + m) * 4 + h) * 2] = wi * 0.08838834764831845f; c.MSC()[(((size_t)dir * MT + m) * 4 + h) * 2 + 1] = 1.0f / fmaxf(fabsf(den), expf(-mt));
}
DEV void st_d7(const Ctx& c, long i) {
    const int col = (int)(i % 512), m = (int)((i / 512) % MT), dir = (int)(i / (512L * MT)), h = col >> 7, e = col & 127, chunk = m >> 6, t = proc_idx(dir, m);
    const size_t oc = ((size_t)dir * NCH + chunk) * 4 + h; const float* Cin = c.MCs() + oc * 16384; const bf16_t* q = c.Pb() + (size_t)m * NP + D_Q + h * 128;
    float a = 0.f; for (int d = 0; d < 128; ++d) a += bf2f(q[d]) * Cin[d * 128 + e];
    const float* sc = c.MSC() + (((size_t)dir * MT + m) * 4 + h) * 2; float num = sc[0] * a;
    const float* W = c.MW() + (oc * 64 + t) * 64;
    for (int s = 0; s <= t; ++s) num += W[s] * bf2f(c.Pb()[(size_t)proc_row(dir, chunk, s) * NP + D_V + col]);
    c.MH()[i] = num * sc[1];
}
DEV void st_d8(const Ctx& c, int l, long i) {
    const int h = (int)(i & 3), m = (int)(i >> 2); const float* h0 = c.MH() + (size_t)m * 512 + h * 128; const float* h1 = h0 + (size_t)MT * 512; const bf16_t* og = c.Pb() + (size_t)m * NP + D_O + h * 128;
    float ss = 0.f; for (int e = 0; e < 128; ++e) { const float v = sigmoidf_(bf2f(og[e])) * (h0[e] + h1[e]); ss += v * v; }
    const float r = 1.0f / sqrtf(ss / 128.f + EPS_);
    for (int e = 0; e < 128; ++e) c.Y()[(size_t)m * DMIX + 1536 + h * 128 + e] = f2bf(sigmoidf_(bf2f(og[e])) * (h0[e] + h1[e]) * r * c.mlstm_norm_w()[l * 512 + h * 128 + e]);
}

DEV void st_b1(const Ctx& c, long i) {
    const int pr = (int)(i & 31), blk = (int)((i >> 5) & 7), which = (int)((i >> 8) & 1), m = (int)(i >> 9);
    const int ii = pr & 15, base = which * 512 + blk * 64 + (pr < 16 ? 0 : 32) + ii; const bf16_t* p = c.Pb() + (size_t)m * NP + B_Q;
    const float va = bf2f(p[base]), vb = bf2f(p[base + 16]); float oa = va, ob = vb;
    if (m < MX) { const int t = m % T_, pos = pr < 16 ? t / GW : t % GW; const float inv = powf(10000.0f, -(float)(2 * ii) / 32.0f), ang = (float)pos * inv, cs = cosf(ang), sn = sinf(ang);
        oa = va * cs - vb * sn; ob = vb * cs + va * sn; }
    c.QKB()[(size_t)m * 1024 + base] = f2bf(oa); c.QKB()[(size_t)m * 1024 + base + 16] = f2bf(ob);
}
DEV void st_b2(const Ctx& c, int ctx_out, long i) {
    const int hf = (int)(i & 3), map = (int)((i >> 2) & 1), h = (int)((i >> 3) & 3), m = (int)(i >> 5);
    if (m >= MX && !ctx_out) return;
    const int b = row_batch(m); float q[64];
#pragma unroll
    for (int d = 0; d < 64; ++d) q[d] = bf2f(c.QKB()[(size_t)m * 1024 + h * 128 + map * 64 + d]) * 0.125f;
    const int nlat = m < MX ? T_ : 0, nk = nlat + TC_;
    float mx = -1e30f, acc[32], den = 0.f;
#pragma unroll
    for (int e = 0; e < 32; ++e) acc[e] = 0.f;
    for (int j = 0; j < nk; ++j) { const int r = j < nlat ? b * T_ + j : MX + b * TC_ + (j - nlat); const bf16_t* k = c.QKB() + (size_t)r * 1024 + 512 + h * 128 + map * 64; float s = 0.f;
#pragma unroll
        for (int d = 0; d < 64; ++d) s += q[d] * bf2f(k[d]);
        if (s > mx) { const float f = expf(mx - s); den *= f;
#pragma unroll
            for (int e = 0; e < 32; ++e) acc[e] *= f;
            mx = s; }
        const float pz = expf(s - mx); den += pz; const bf16_t* v = c.Pb() + (size_t)r * NP + B_V + h * 128 + hf * 32;
#pragma unroll
        for (int e = 0; e < 32; ++e) acc[e] += pz * bf2f(v[e]); }
    const float rd = 1.0f / den; float* o = c.DO() + ((size_t)map * MT + m) * 512 + h * 128 + hf * 32;
#pragma unroll
    for (int e = 0; e < 32; ++e) o[e] = acc[e] * rd;
}
DEV void st_b3(const Ctx& c, int l, long i) {
    const int h = (int)(i & 3), m = (int)(i >> 2); const float lamf = c.LAMF()[2 * l], li = c.LAMF()[2 * l + 1];
    const float* o0 = c.DO() + (size_t)m * 512 + h * 128; const float* o1 = o0 + (size_t)MT * 512;
    float ss = 0.f; for (int e = 0; e < 128; ++e) { const float v = o0[e] - lamf * o1[e]; ss += v * v; }
    const float r = 1.0f / sqrtf(ss / 128.f + EPS_);
    for (int e = 0; e < 128; ++e) c.Y()[(size_t)m * DMIX + 512 + h * 128 + e] = f2bf((o0[e] - lamf * o1[e]) * r * c.diff_norm_w()[l * 512 + h * 128 + e] * (1.0f - li));
}

DEV int na_key_row(int m, int j, int& roff, int& coff) {
    const int b = m / T_, t = m % T_, r = t / GW, wq = t % GW;
    if (j >= 128) { roff = -1; coff = -1; return MX + b * TC_ + (j - 128); }
    const int rs = iclip(r - 4, 0, ROWS - 8), cs = iclip(wq - 8, 0, GW - 16), kr = rs + (j >> 4), kc = cs + (j & 15);
    roff = kr - r + 7; coff = iclip(kc - wq, -15, 15) + 15; return b * T_ + kr * GW + kc;
}
DEV void st_c1(const Ctx& c, int l, long i) {
    const int j = (int)(i % NSW), h = (int)((i / NSW) & 3), m = (int)(i / (4L * NSW));
    int kr, roff = -1, coff = -1;
    if (m < MX) kr = na_key_row(m, j, roff, coff); else { if (j >= TC_) return; kr = MX + row_batch(m) * TC_ + j; }
    const bf16_t* q = c.Pb() + (size_t)m * NP + C_Q + h * 128; const bf16_t* k = c.Pb() + (size_t)kr * NP + C_K + h * 128;
    float s = 0.f; for (int d = 0; d < 128; ++d) s += bf2f(q[d]) * bf2f(k[d]);
    s *= 0.08838834764831845f;
    if (roff >= 0) s += c.na_rpb()[((l * 4 + h) * 15 + roff) * 31 + coff];
    c.NS()[i] = s;
}
DEV void st_c2(const Ctx& c, long i) {
    const int m = (int)(i >> 2); const int n = m < MX ? NSW : TC_; float* s = c.NS() + i * NSW;
    float mx = -1e30f; for (int j = 0; j < n; ++j) mx = fmaxf(mx, s[j]);
    float den = 0.f; for (int j = 0; j < n; ++j) { const float e = expf(s[j] - mx); s[j] = e; den += e; }
    const float r = 1.0f / den; for (int j = 0; j < n; ++j) s[j] *= r;
}
DEV void st_c3(const Ctx& c, long i) {
    const int col = (int)(i % 512), m = (int)(i / 512), h = col >> 7; const float* p = c.NS() + ((size_t)m * 4 + h) * NSW; float o = 0.f;
    if (m < MX) { for (int j = 0; j < NSW; ++j) { int ro, co; const int kr = na_key_row(m, j, ro, co); o += p[j] * bf2f(c.Pb()[(size_t)kr * NP + C_V + col]); } }
    else { const int b = row_batch(m); for (int j = 0; j < TC_; ++j) o += p[j] * bf2f(c.Pb()[(size_t)(MX + b * TC_ + j) * NP + C_V + col]); }
    c.Y()[(size_t)m * DMIX + 1024 + col] = f2bf(o);
}

DEV void st_conv(const Ctx& c, int l, long i) {
    const int j = (int)(i % FF_), m = (int)(i / FF_), pos = row_pos(m), len = row_len(m); float v[2];
#pragma unroll
    for (int hf = 0; hf < 2; ++hf) { const int cc = hf * FF_ + j; float s = c.conv_b()[(size_t)l * FF2 + cc];
        for (int dt = -1; dt <= 1; ++dt) if (pos + dt >= 0 && pos + dt < len) s += c.conv_w()[((size_t)l * 3 + dt + 1) * FF2 + cc] * bf2f(c.U()[(size_t)(m + dt) * FF2 + cc]);
        v[hf] = s; }
    c.ACT()[i] = f2bf(siluf_(v[0]) * v[1]);
}
DEV void st_final(const Ctx& c, long i) { const int m = (int)(i / D_), col = (int)(i % D_); c.out()[i] = c.X()[i] * c.RSTD()[m] * c.final_norm_w()[col]; }
constexpr int PH_PRO = 3, PH_LAYER = 17, PH_FIN = 3, NPH = PH_PRO + L_ * PH_LAYER + PH_FIN;
namespace fa {
typedef short bf16x8 __attribute__((ext_vector_type(8)));
typedef short s16x4 __attribute__((ext_vector_type(4)));
typedef float f32x16 __attribute__((ext_vector_type(16)));
typedef float f32x2 __attribute__((ext_vector_type(2)));
typedef __bf16 bf16x2 __attribute__((ext_vector_type(2)));
typedef unsigned u32x4 __attribute__((ext_vector_type(4)));
typedef unsigned u32x2 __attribute__((ext_vector_type(2)));
constexpr int KOFF0 = 0, VOFF0 = 32768, BUFB = 16384, XOFF = 0, RPB_OFF = 65536, RPB_PAD = 48, FA_LDS = 65536 + 4 * (15 * 31 + 2 * 48);
constexpr float LOG2E = 1.4426950408889634f;

DEV unsigned pk2(float a, float b) { const f32x2 v = {a, b}; return __builtin_bit_cast(unsigned, __builtin_convertvector(v, bf16x2)); }
DEV unsigned off_a(unsigned row, unsigned ch) { return 2048u * (row >> 3) + 512u * (ch >> 2) + 64u * (row & 7) + 16u * ((ch & 3) ^ ((row >> 2) & 3)); }
DEV int crow(int reg, int h) { return (reg & 3) + 8 * (reg >> 2) + 4 * h; }
DEV bf16x8 pack8(const f32x16& x, int s8) {
    u32x4 p; p.x = pk2(x[s8 + 0], x[s8 + 1]); p.y = pk2(x[s8 + 2], x[s8 + 3]); p.z = pk2(x[s8 + 4], x[s8 + 5]); p.w = pk2(x[s8 + 6], x[s8 + 7]); return __builtin_bit_cast(bf16x8, p);
}
DEV float max3_(float a, float b, float c) { float r; asm("v_max3_f32 %0, %1, %2, %3" : "=v"(r) : "v"(a), "v"(b), "v"(c)); return r; }
DEV float max2_(float a, float b) { float r; asm("v_max_f32 %0, %1, %2" : "=v"(r) : "v"(a), "v"(b)); return r; }
DEV float xhalf_sum(float v) { const auto rr = __builtin_amdgcn_permlane32_swap(__builtin_bit_cast(unsigned, v), __builtin_bit_cast(unsigned, v), false, false); return __builtin_bit_cast(float, (unsigned)rr[0]) + __builtin_bit_cast(float, (unsigned)rr[1]); }
DEV float xhalf_max(float v) { const auto rr = __builtin_amdgcn_permlane32_swap(__builtin_bit_cast(unsigned, v), __builtin_bit_cast(unsigned, v), false, false); return max2_(__builtin_bit_cast(float, (unsigned)rr[0]), __builtin_bit_cast(float, (unsigned)rr[1])); }
template <int K> DEV float swz_xor(float v) { return __builtin_bit_cast(float, __builtin_amdgcn_ds_swizzle(__builtin_bit_cast(int, v), (K << 10) | 0x1f)); }
DEV float bperm(float v, int src_lane) { return __builtin_bit_cast(float, __builtin_amdgcn_ds_bpermute(src_lane << 2, __builtin_bit_cast(int, v))); }
}
DEV float fexp_(float x) { return __builtin_amdgcn_exp2f(x * 1.4426950408889634f); }
DEV float flog_(float x) { return __builtin_amdgcn_logf(x) * 0.6931471805599453f; }
DEV float fsig_(float x) { return __builtin_amdgcn_rcpf(1.0f + __builtin_amdgcn_exp2f(x * -1.4426950408889634f)); }
DEV float fsilu_(float x) { return x * fsig_(x); }
namespace fa {

struct Unit {
    const bf16_t* Qp; int ldq;
    const bf16_t* Kp; int ldk;
    const bf16_t* Vp; int ldv;
    int rowA, nA, rowB, nB;
};

template <int MODE>
DEV void flash_unit(LAS unsigned char* lds, const int tid, const Unit u, int map, int band, int kr_lo, int r, int wq, f32x16 (&o)[4], float& lsum) {
    const int lane = tid & 63, r32 = lane & 31, h = lane >> 5;
    constexpr int KS = MODE == 0 ? 4 : 8;
    constexpr float C = (MODE == 0 ? 0.125f : 0.08838834764831845f) * LOG2E;
    bf16x8 qf[KS];
#pragma unroll
    for (int s = 0; s < KS; ++s) qf[s] = *(const bf16x8*)(u.Qp + (size_t)r32 * u.ldq + 16 * s + 8 * h);
    unsigned ka[2], va[2];
#pragma unroll
    for (int par = 0; par < 2; ++par) ka[par] = 2048u * (r32 >> 3) + 64u * (r32 & 7) + 16u * ((2u * par + h) ^ ((r32 >> 2) & 3)) + (MODE == 0 ? 1024u * map : 0u);
    { const unsigned q4 = (lane & 15) >> 2, p = lane & 3, blk = (lane >> 4) & 1;
#pragma unroll
      for (int t = 0; t < 2; ++t) va[t] = 2048u * t + 64u * (4u * h + q4) + 16u * ((2u * blk + (p >> 1)) ^ ((2u * t + h) & 3)) + 8u * (p & 1); }
    const int wv = __builtin_amdgcn_readfirstlane(tid >> 6);
    const int nt = u.nA + u.nB;
    unsigned goK[2], goV[2];
#pragma unroll
    for (int j = 0; j < 2; ++j) { const int q = 2 * wv + j, sub = q >> 3, rg = (q >> 1) & 3, chh = q & 1, c2 = lane >> 5, r7 = (lane >> 2) & 7, x = lane & 3;
        const int row = 32 * sub + 8 * rg + r7, ch = 8 * chh + 4 * c2 + (x ^ ((2 * rg + (r7 >> 2)) & 3));
        goK[j] = (unsigned)(row * u.ldk + ch * 8) * 2u; goV[j] = (unsigned)(row * u.ldv + ch * 8) * 2u; }
#define FA_ROW0(t) ((t) < u.nA ? u.rowA + 64 * (t) : u.rowB + 64 * ((t) - u.nA))
#define FA_DMA(t, buf) do { const int row0_ = FA_ROW0(t); const char* kb_ = (const char*)(u.Kp + (size_t)row0_ * u.ldk); const char* vb_ = (const char*)(u.Vp + (size_t)row0_ * u.ldv); \
        _Pragma("unroll") for (int j_ = 0; j_ < 2; ++j_) { \
            __builtin_amdgcn_global_load_lds((const unsigned*)(kb_ + goK[j_]), (LAS unsigned*)(lds + KOFF0 + (buf) * BUFB + (2 * wv + j_) * 1024), 16, 0, 0); \
            __builtin_amdgcn_global_load_lds((const unsigned*)(vb_ + goV[j_]), (LAS unsigned*)(lds + VOFF0 + (buf) * BUFB + (2 * wv + j_) * 1024), 16, 0, 0); } } while (0)
#define FA_LANDED asm volatile("s_waitcnt vmcnt(0)" ::: "memory")
    FA_DMA(0, 0);
    FA_LANDED; __syncthreads();
#pragma unroll
    for (int c = 0; c < 4; ++c)
#pragma unroll
        for (int i = 0; i < 16; ++i) o[c][i] = 0.f;
    float m = -1e30f; lsum = 0.f;
    const int rs = MODE == 1 ? iclip(r - 4, 0, ROWS - 8) : 0, cs = MODE == 1 ? iclip(wq - 8, 0, GW - 16) : 0;
#define FA_TILE(BUF_, TT_) do { \
        bool active = true; int kr = 0; \
        if (MODE == 1 && band && (TT_) < u.nA) { kr = kr_lo + (TT_); active = kr >= rs && kr < rs + 8; } \
        if (active) { \
            f32x16 p0, p1; \
_Pragma("unroll") \
            for (int i = 0; i < 16; ++i) { p0[i] = 0.f; p1[i] = 0.f; } \
_Pragma("unroll") \
            for (int sc = 0; sc < KS; sc += 4) { bf16x8 kf0[4], kf1[4]; \
_Pragma("unroll") \
                for (int s = 0; s < 4; ++s) { kf0[s] = *(const LAS bf16x8*)(lds + KOFF0 + (BUF_) * BUFB + ka[s & 1] + 512 * ((sc + s) >> 1)); \
                    kf1[s] = *(const LAS bf16x8*)(lds + KOFF0 + (BUF_) * BUFB + ka[s & 1] + 512 * ((sc + s) >> 1) + 8192); } \
_Pragma("unroll") \
                for (int s = 0; s < 4; ++s) { p0 = __builtin_amdgcn_mfma_f32_32x32x16_bf16(kf0[s], qf[sc + s], p0, 0, 0, 0); p1 = __builtin_amdgcn_mfma_f32_32x32x16_bf16(kf1[s], qf[sc + s], p1, 0, 0, 0); } \
                __builtin_amdgcn_sched_group_barrier(0x100, 8, 0); __builtin_amdgcn_sched_group_barrier(0x008, 8, 0); \
            } \
            asm volatile("s_nop 7\n\ts_nop 7\n\ts_nop 3" : "+v"(p0), "+v"(p1));       \
            const bool bandt = MODE == 1 && band && (TT_) < u.nA; \
            if (bandt) { \
                const LAS float* rp = (const LAS float*)(lds + RPB_OFF) + RPB_PAD + (kr - r + 7) * 31 + 15 - wq + 4 * h;        \
                float bz0[16], bz1[16]; \
_Pragma("unroll") \
                for (int i = 0; i < 16; ++i) { bz0[i] = rp[crow(i, 0)]; bz1[i] = rp[crow(i, 0) + 32]; } \
_Pragma("unroll") \
                for (int i = 0; i < 16; ++i) { const int kc0 = crow(i, 0) + 4 * h, kc1 = kc0 + 32; \
                    p0[i] = (unsigned)(kc0 - cs) < 16u ? p0[i] * C + bz0[i] : -1e30f; \
                    p1[i] = (unsigned)(kc1 - cs) < 16u ? p1[i] * C + bz1[i] : -1e30f; } \
            } \
            float pm = max3_(p0[0], p1[0], p0[1]), pm2 = max3_(p1[1], p0[2], p1[2]); \
_Pragma("unroll") \
            for (int i = 3; i < 15; i += 2) { pm = max3_(pm, p0[i], p1[i]); pm2 = max3_(pm2, p0[i + 1], p1[i + 1]); } \
            pm = xhalf_max(max3_(pm, pm2, max2_(p0[15], p1[15]))); \
            if (!bandt) pm *= C; \
            const float mn = max2_(m, pm); \
            if (__builtin_amdgcn_ballot_w64(mn > m) != 0ull) { \
                const float alpha = __builtin_amdgcn_exp2f(m - mn); m = mn; lsum *= alpha; \
_Pragma("unroll") \
                for (int c = 0; c < 4; ++c) o[c] = o[c] * alpha; \
            } \
            if (bandt) { p0 = p0 - m; p1 = p1 - m; } else { p0 = p0 * C - m; p1 = p1 * C - m; } \
            float rsum = 0.f; \
_Pragma("unroll") \
            for (int i = 0; i < 16; ++i) { p0[i] = __builtin_amdgcn_exp2f(p0[i]); p1[i] = __builtin_amdgcn_exp2f(p1[i]); } \
            { const f32x16 ps = p0 + p1; \
_Pragma("unroll") \
              for (int i = 0; i < 16; ++i) rsum += ps[i]; } \
            rsum = xhalf_sum(rsum); \
            lsum += rsum; \
            const bf16x8 pb00 = pack8(p0, 0), pb01 = pack8(p0, 8), pb10 = pack8(p1, 0), pb11 = pack8(p1, 8); \
            { s16x4 vt[2][4][2];                   \
_Pragma("unroll") \
              for (int c = 0; c < 4; ++c) { const unsigned base = VOFF0 + (BUF_) * BUFB + 512 * c; \
                  vt[0][c][0] = __builtin_amdgcn_ds_read_tr16_b64_v4i16((LAS s16x4*)(lds + base + va[0])); vt[0][c][1] = __builtin_amdgcn_ds_read_tr16_b64_v4i16((LAS s16x4*)(lds + base + va[1])); } \
              __builtin_amdgcn_sched_group_barrier(0x100, 8, 0); \
_Pragma("unroll") \
              for (int g = 0; g < 4; ++g) { \
                  if (g < 3) { \
_Pragma("unroll") \
                      for (int c = 0; c < 4; ++c) { const unsigned base = VOFF0 + (BUF_) * BUFB + 8192 * ((g + 1) >> 1) + 4096 * ((g + 1) & 1) + 512 * c; \
                          vt[(g + 1) & 1][c][0] = __builtin_amdgcn_ds_read_tr16_b64_v4i16((LAS s16x4*)(lds + base + va[0])); vt[(g + 1) & 1][c][1] = __builtin_amdgcn_ds_read_tr16_b64_v4i16((LAS s16x4*)(lds + base + va[1])); } \
                      __builtin_amdgcn_sched_group_barrier(0x100, 8, 0); } \
                  const bf16x8 pb = g == 0 ? pb00 : (g == 1 ? pb01 : (g == 2 ? pb10 : pb11)); \
_Pragma("unroll") \
                  for (int c = 0; c < 4; ++c) { const s16x4 t0 = vt[g & 1][c][0], t1 = vt[g & 1][c][1]; const bf16x8 a = {t0[0], t0[1], t0[2], t0[3], t1[0], t1[1], t1[2], t1[3]}; \
                      o[c] = __builtin_amdgcn_mfma_f32_32x32x16_bf16(a, pb, o[c], 0, 0, 0); } \
                  __builtin_amdgcn_sched_group_barrier(0x008, 4, 0); } } \
        } \
    } while (0)
    for (int t = 0; t < nt; t += 2) {
        if (t + 1 < nt) FA_DMA(t + 1, 1);
        FA_TILE(0, t);
        FA_LANDED; __syncthreads();
        if (t + 1 >= nt) break;
        if (t + 2 < nt) FA_DMA(t + 2, 0);
        FA_TILE(1, t + 1);
        FA_LANDED; __syncthreads();
    }
#undef FA_TILE
#undef FA_ROW0
#undef FA_DMA
#undef FA_LANDED
}

DEV void diff_unit(const Ctx& c, int l, LAS unsigned char* lds, int unit) {
    int tid_ = threadIdx.x; asm volatile("" : "+v"(tid_));
    const int tid = tid_, w = __builtin_amdgcn_readfirstlane(tid >> 6), lane = tid & 63, r32 = lane & 31, h = lane >> 5, map = w & 1;
    int b, hh, qbase; Unit u;
    if (unit < B_ * 4 * (T_ / 128)) { const int qb = unit % (T_ / 128); hh = (unit / (T_ / 128)) & 3; b = unit / (4 * (T_ / 128)); qbase = b * T_ + 128 * qb;
        u.rowA = b * T_; u.nA = T_ / 64; u.rowB = MX + b * TC_; u.nB = TC_ / 64; }
    else { const int v = unit - B_ * 4 * (T_ / 128); const int qb = v % (TC_ / 128); hh = (v / (TC_ / 128)) & 3; b = v / (4 * (TC_ / 128)); qbase = MX + b * TC_ + 128 * qb;
        u.rowA = MX + b * TC_; u.nA = TC_ / 64; u.rowB = 0; u.nB = 0; }
    const int qrow0 = qbase + 32 * (w >> 1);
    u.Qp = c.QKB() + (size_t)qrow0 * 1024 + hh * 128 + map * 64; u.ldq = 1024;
    u.Kp = c.QKB() + 512 + hh * 128; u.ldk = 1024;
    u.Vp = c.Pb() + B_V + hh * 128; u.ldv = NP;
    f32x16 o[4]; float lsum;
    flash_unit<0>(lds, tid, u, map, 0, 0, 0, 0, o, lsum);
    const float inv = 1.0f / lsum;
    LAS float* xb = (LAS float*)(lds + XOFF) + (w >> 1) * 4096;
    if (map == 1) {
#pragma unroll
        for (int cc = 0; cc < 4; ++cc)
#pragma unroll
            for (int i = 0; i < 16; ++i) xb[(32 * cc + crow(i, h)) * 32 + r32] = o[cc][i] * inv;
    }
    __syncthreads();
    if (map == 0) {
        const float lamf = c.LAMF()[2 * l], li = c.LAMF()[2 * l + 1]; float ss = 0.f;
#pragma unroll
        for (int cc = 0; cc < 4; ++cc)
#pragma unroll
            for (int i = 0; i < 16; ++i) { const float d = o[cc][i] * inv - lamf * xb[(32 * cc + crow(i, h)) * 32 + r32]; o[cc][i] = d; ss += d * d; }
        ss = xhalf_sum(ss);
        const float rr = (1.0f - li) / sqrtf(ss * (1.0f / 128.f) + EPS_);
        const float* nw = c.diff_norm_w() + l * 512 + hh * 128; bf16_t* yp = c.Y() + (size_t)(qrow0 + r32) * DMIX + 512 + hh * 128;
#pragma unroll
        for (int cc = 0; cc < 4; ++cc)
#pragma unroll
            for (int g = 0; g < 4; ++g) { const int e = 32 * cc + 8 * g + 4 * h; const float4 wv = *(const float4*)(nw + e);
                u32x2 pk; pk.x = pk2(o[cc][4 * g] * rr * wv.x, o[cc][4 * g + 1] * rr * wv.y); pk.y = pk2(o[cc][4 * g + 2] * rr * wv.z, o[cc][4 * g + 3] * rr * wv.w);
                *(u32x2*)(yp + e) = pk; }
    }
    __syncthreads();
}
constexpr int N_DIFF_LAT = B_ * 4 * (T_ / 128), N_DIFF_CTX = B_ * 4 * (TC_ / 128);

DEV void na_unit(const Ctx& c, int l, LAS unsigned char* lds, int unit) {
    int tid_ = threadIdx.x; asm volatile("" : "+v"(tid_));
    const int tid = tid_, w = __builtin_amdgcn_readfirstlane(tid >> 6), lane = tid & 63, r32 = lane & 31, h = lane >> 5;
    int b, hh, qbase, band, kr_lo = 0, r = 0, wq = 0; Unit u;
    constexpr int RG = ROWS / 4;
    if (unit < B_ * 4 * RG) { const int rg = unit % RG; hh = (unit / RG) & 3; b = unit / (4 * RG); qbase = b * T_ + 256 * rg; band = 1;
        const int r0 = 4 * rg; kr_lo = iclip(r0 - 4, 0, ROWS - 8); const int kr_hi = iclip(r0 + 3 - 4, 0, ROWS - 8) + 7;
        u.rowA = b * T_ + 64 * kr_lo; u.nA = kr_hi - kr_lo + 1; u.rowB = MX + b * TC_; u.nB = TC_ / 64; r = r0 + (w >> 1); wq = 32 * (w & 1) + r32; }
    else { const int v = unit - B_ * 4 * RG; hh = v & 3; b = v >> 2; qbase = MX + b * TC_; band = 0; u.rowA = MX + b * TC_; u.nA = TC_ / 64; u.rowB = 0; u.nB = 0; }
    const int qrow0 = qbase + 32 * w;
    u.Qp = c.Pb() + (size_t)qrow0 * NP + C_Q + hh * 128; u.ldq = NP;
    u.Kp = c.Pb() + C_K + hh * 128; u.ldk = NP;
    u.Vp = c.Pb() + C_V + hh * 128; u.ldv = NP;
    if (band) { for (int i = tid; i < 15 * 31; i += 512) ((LAS float*)(lds + RPB_OFF))[RPB_PAD + i] = c.na_rpb()[(size_t)(l * 4 + hh) * 465 + i] * LOG2E; }
    f32x16 o[4]; float lsum;
    flash_unit<1>(lds, tid, u, 0, band, kr_lo, r, wq, o, lsum);
    const float inv = 1.0f / lsum; bf16_t* yp = c.Y() + (size_t)(qrow0 + r32) * DMIX + 1024 + hh * 128;
#pragma unroll
    for (int cc = 0; cc < 4; ++cc)
#pragma unroll
        for (int g = 0; g < 4; ++g) { const int e = 32 * cc + 8 * g + 4 * h;
            u32x2 pk; pk.x = pk2(o[cc][4 * g] * inv, o[cc][4 * g + 1] * inv); pk.y = pk2(o[cc][4 * g + 2] * inv, o[cc][4 * g + 3] * inv);
            *(u32x2*)(yp + e) = pk; }
    __syncthreads();
}
constexpr int N_NA_LAT = B_ * 4 * (ROWS / 4), N_NA_CTX = B_ * 4;
}
namespace ch {
using fa::bf16x8; using fa::s16x4; using fa::f32x16; using fa::u32x4; using fa::u32x2; using fa::pk2; using fa::off_a; using fa::crow; using fa::xhalf_sum;
typedef float f32x4 __attribute__((ext_vector_type(4)));
DEV bf16x8 pack8f(const f32x4 a, const f32x4 b) { u32x4 p; p.x = pk2(a[0], a[1]); p.y = pk2(a[2], a[3]); p.z = pk2(b[0], b[1]); p.w = pk2(b[2], b[3]); return __builtin_bit_cast(bf16x8, p); }
DEV float bfe(const bf16x8 v, int j) { return bf2f((bf16_t)v[j]); }
DEV unsigned nat_base(int lane, int t) { const unsigned h = lane >> 5, blk = (lane >> 4) & 1, q4 = (lane & 15) >> 2, p = lane & 3;
    return 2048u * h + 64u * (4u * t + q4) + 16u * ((2u * blk + (p >> 1)) ^ ((2u * h + t) & 3)) + 8u * (p & 1); }
DEV bf16x8 tr_frag(LAS unsigned char* lds, unsigned off, const unsigned (&nb)[2]) {
    const s16x4 t0 = __builtin_amdgcn_ds_read_tr16_b64_v4i16((LAS s16x4*)(lds + off + nb[0]));
    const s16x4 t1 = __builtin_amdgcn_ds_read_tr16_b64_v4i16((LAS s16x4*)(lds + off + nb[1]));
    return (bf16x8){t0[0], t0[1], t0[2], t0[3], t1[0], t1[1], t1[2], t1[3]};
}
DEV unsigned row_base(int lane, int par) { const unsigned r32 = lane & 31, h = lane >> 5; return 2048u * (r32 >> 3) + 64u * (r32 & 7) + 16u * ((2u * par + h) ^ ((r32 >> 2) & 3)); }

template <int MODE>
DEV void local_state_unit(const Ctx& c, LAS unsigned char* lds, const int tid, const int unit) {
    constexpr int KT = 0, VT = 16384;
    const int lane = tid & 63, w = __builtin_amdgcn_readfirstlane(tid >> 6), r32 = lane & 31, h = lane >> 5;
    const int hh = unit & 3, chunk = (unit >> 2) % NCH, dir = (unit >> 2) / NCH;
    const int srow = tid >> 4, sch = tid & 15; const unsigned soff = off_a(srow, sch);
#pragma unroll
    for (int i = 0; i < 2; ++i) { const int m = chunk * 64 + srow + 32 * i;
        const bf16x8 vv = *(const bf16x8*)(c.Pb() + (size_t)m * NP + (MODE == 0 ? A_I : D_V) + hh * 128 + sch * 8);
        bf16x8 kt;
        if (MODE == 0) { const size_t o = ((size_t)dir * MT + m) * 512 + hh * 128 + sch * 8; const float* blp = c.BL() + ((size_t)dir * NCH + chunk) * 512 + hh * 128 + sch * 8;
            const f32x4 k0 = *(const f32x4*)(c.KK() + o), k1 = *(const f32x4*)(c.KK() + o + 4), b0 = *(const f32x4*)(c.BC() + o), b1 = *(const f32x4*)(c.BC() + o + 4), l0 = *(const f32x4*)blp, l1 = *(const f32x4*)(blp + 4);
            f32x4 x0, x1;
#pragma unroll
            for (int j = 0; j < 4; ++j) { x0[j] = k0[j] * fexp_(l0[j] - b0[j]); x1[j] = k1[j] * fexp_(l1[j] - b1[j]); }
            kt = pack8f(x0, x1);
        } else { const bf16x8 kr = *(const bf16x8*)(c.Pb() + (size_t)m * NP + D_K + hh * 128 + sch * 8); const float wu = c.MWU()[((size_t)dir * MT + m) * 4 + hh];
            f32x4 x0, x1;
#pragma unroll
            for (int j = 0; j < 4; ++j) { x0[j] = wu * bfe(kr, j); x1[j] = wu * bfe(kr, 4 + j); }
            kt = pack8f(x0, x1); }
        *(LAS bf16x8*)(lds + KT + soff + 8192 * i) = kt; *(LAS bf16x8*)(lds + VT + soff + 8192 * i) = vv; }
    __syncthreads();
    unsigned nb[2]; nb[0] = nat_base(lane, 0); nb[1] = nat_base(lane, 1);
    const int dc = w >> 1, ec0 = (w & 1) * 2;
    f32x16 acc[2];
#pragma unroll
    for (int i = 0; i < 16; ++i) { acc[0][i] = 0.f; acc[1][i] = 0.f; }
#pragma unroll
    for (int sub = 0; sub < 2; ++sub)
#pragma unroll
        for (int ks = 0; ks < 2; ++ks) { const bf16x8 a = tr_frag(lds, KT + 8192 * sub + 4096 * ks + 512 * dc, nb);
#pragma unroll
            for (int e2 = 0; e2 < 2; ++e2) { const bf16x8 b = tr_frag(lds, VT + 8192 * sub + 4096 * ks + 512 * (ec0 + e2), nb); acc[e2] = __builtin_amdgcn_mfma_f32_32x32x16_bf16(a, b, acc[e2], 0, 0, 0); } }
    float* dst = (MODE == 0 ? c.HST() : c.MCs()) + (size_t)unit * 16384;
#pragma unroll
    for (int e2 = 0; e2 < 2; ++e2)
#pragma unroll
        for (int i = 0; i < 16; ++i) dst[(32 * dc + crow(i, h)) * 128 + 32 * (ec0 + e2) + r32] = acc[e2][i];
    if (MODE == 1 && tid < 128) { float sn = 0.f;
        for (int j = 0; j < 64; ++j) sn += bf2f(*(const LAS bf16_t*)(lds + KT + off_a(j & 31, tid >> 3) + 8192 * (j >> 5) + (tid & 7) * 2));
        c.MN()[(size_t)unit * 128 + tid] = sn; }
    __syncthreads();
}

DEV void mlstm_out2_unit(const Ctx& c, int l, LAS unsigned char* lds, const int tid, const int unit) {
    constexpr int QO = 0, KO = 16384, VO = 32768, SO = 49152, WO = 81920, TBL = 91136, SSQ = 94208;
    constexpr float SCALE = 0.08838834764831845f;
    const int lane = tid & 63, w = __builtin_amdgcn_readfirstlane(tid >> 6), r32 = lane & 31, h = lane >> 5;
    const int hh = unit & 3, chunk = unit >> 2, m0 = chunk * 64;
    LAS float* TB = (LAS float*)(lds + TBL); LAS float* TA = TB + 64; LAS float* TM = TB + 128; LAS float* TWI = TB + 192; LAS float* QN = TB + 256; LAS float* NIN = TB + 320;
    const int srow = tid >> 4, sch = tid & 15; const unsigned soff = off_a(srow, sch);
#pragma unroll
    for (int i = 0; i < 2; ++i) { const bf16_t* p = c.Pb() + (size_t)(m0 + srow + 32 * i) * NP + hh * 128 + sch * 8;
        *(LAS bf16x8*)(lds + QO + soff + 8192 * i) = *(const bf16x8*)(p + D_Q); *(LAS bf16x8*)(lds + KO + soff + 8192 * i) = *(const bf16x8*)(p + D_K); *(LAS bf16x8*)(lds + VO + soff + 8192 * i) = *(const bf16x8*)(p + D_V); }
    unsigned rb[2], nb[2]; rb[0] = row_base(lane, 0); rb[1] = row_base(lane, 1); nb[0] = nat_base(lane, 0); nb[1] = nat_base(lane, 1);
    const int cc = w >> 1, tb = w & 1, rt = 32 * tb + r32;
    f32x16 p, tot;
#pragma unroll
    for (int i = 0; i < 16; ++i) { p[i] = 0.f; tot[i] = 0.f; }
    for (int dir = 0; dir < 2; ++dir) {
        const int uo = (dir * NCH + chunk) * 4 + hh;
#pragma unroll
        for (int i = 0; i < 4; ++i) { const int d = srow + 32 * i; *(LAS bf16x8*)(lds + SO + soff + 8192 * i) = *(const bf16x8*)(c.MSB() + (size_t)uo * 16384 + d * 128 + sch * 8); }
        if (tid < 64) { const size_t o = ((size_t)dir * MT + m0 + tid) * 4 + hh; const float b = c.MB()[o]; TB[tid] = b; TA[tid] = c.MLI()[o] - b; }
        else if (tid < 192) NIN[tid - 64] = c.MN()[(size_t)uo * 128 + tid - 64];
        __syncthreads();
        if (tid < 64) { const int r0 = tid; const float bt = TB[r0], inter = bt + c.MMIN()[uo]; float mx = inter;
            for (int rs = 0; rs < 64; ++rs) { const bool ok = dir ? rs >= r0 : rs <= r0; if (ok) mx = fmaxf(mx, bt + TA[rs]); }
            TM[r0] = mx; TWI[r0] = fexp_(inter - mx); }
        else if (tid >= 256 && tid < 320) { const int t = tid - 256; float s = 0.f;
            for (int d = 0; d < 128; ++d) s += bf2f(*(const LAS bf16_t*)(lds + QO + off_a(t & 31, d >> 3) + 8192 * (t >> 5) + (d & 7) * 2)) * NIN[d];
            QN[t] = s * SCALE; }
        if (dir == 0 && w < 4) {
            const int st = w >> 1, tt = w & 1;
#pragma unroll
            for (int s8 = 0; s8 < 8; ++s8) { const bf16x8 a = *(const LAS bf16x8*)(lds + KO + 8192 * st + rb[s8 & 1] + 512 * (s8 >> 1)); const bf16x8 b = *(const LAS bf16x8*)(lds + QO + 8192 * tt + rb[s8 & 1] + 512 * (s8 >> 1));
                p = __builtin_amdgcn_mfma_f32_32x32x16_bf16(a, b, p, 0, 0, 0); } }
        __syncthreads();
        if (w < 4) {
            const int st = w >> 1, tt = w & 1, r0 = 32 * tt + r32; const float bt = TB[r0] - TM[r0];
#pragma unroll
            for (int g = 0; g < 4; ++g) { float wv[4];
#pragma unroll
                for (int j = 0; j < 4; ++j) { const int rs = 32 * st + 8 * g + 4 * h + j; const bool ok = dir ? rs >= r0 : rs <= r0; wv[j] = ok ? fexp_(bt + TA[rs]) * p[4 * g + j] * SCALE : 0.f; }
                u32x2 pk; pk.x = pk2(wv[0], wv[1]); pk.y = pk2(wv[2], wv[3]);
                *(LAS u32x2*)(lds + WO + r0 * 144 + (32 * st + 8 * g + 4 * h) * 2) = pk; } }
        __syncthreads();
        { f32x16 acc;
#pragma unroll
          for (int i = 0; i < 16; ++i) acc[i] = 0.f;
#pragma unroll
          for (int s8 = 0; s8 < 8; ++s8) { const bf16x8 a = tr_frag(lds, SO + 8192 * (s8 >> 1) + 4096 * (s8 & 1) + 512 * cc, nb); const bf16x8 b = *(const LAS bf16x8*)(lds + QO + 8192 * tb + rb[s8 & 1] + 512 * (s8 >> 1));
              acc = __builtin_amdgcn_mfma_f32_32x32x16_bf16(a, b, acc, 0, 0, 0); }
          const float wi = TWI[rt], ws = wi * SCALE;
#pragma unroll
          for (int i = 0; i < 16; ++i) acc[i] *= ws;
          float rsum = 0.f;
#pragma unroll
          for (int k4 = 0; k4 < 4; ++k4) { const bf16x8 b = *(const LAS bf16x8*)(lds + WO + rt * 144 + (16 * k4 + 8 * h) * 2);
#pragma unroll
              for (int j = 0; j < 8; ++j) rsum += bfe(b, j);
              const bf16x8 a = tr_frag(lds, VO + 8192 * (k4 >> 1) + 4096 * (k4 & 1) + 512 * cc, nb);
              acc = __builtin_amdgcn_mfma_f32_32x32x16_bf16(a, b, acc, 0, 0, 0); }
          rsum = xhalf_sum(rsum);
          const float den = wi * QN[rt] + rsum, rinv = 1.0f / fmaxf(fabsf(den), fexp_(-TM[rt]));
#pragma unroll
          for (int i = 0; i < 16; ++i) tot[i] += acc[i] * rinv; }
        __syncthreads();
    }
    { const bf16_t* og = c.Pb() + (size_t)(m0 + rt) * NP + D_O + hh * 128 + 32 * cc + 4 * h; float ss = 0.f;
#pragma unroll
      for (int g = 0; g < 4; ++g) { const u32x2 gv = *(const u32x2*)(og + 8 * g);
          const float g0 = bf2f((bf16_t)(gv.x & 0xffffu)), g1 = bf2f((bf16_t)(gv.x >> 16)), g2 = bf2f((bf16_t)(gv.y & 0xffffu)), g3 = bf2f((bf16_t)(gv.y >> 16));
          tot[4 * g] *= fsig_(g0); tot[4 * g + 1] *= fsig_(g1); tot[4 * g + 2] *= fsig_(g2); tot[4 * g + 3] *= fsig_(g3);
          ss += tot[4 * g] * tot[4 * g] + tot[4 * g + 1] * tot[4 * g + 1] + tot[4 * g + 2] * tot[4 * g + 2] + tot[4 * g + 3] * tot[4 * g + 3]; }
      ss = xhalf_sum(ss);
      LAS float* SQ = (LAS float*)(lds + SSQ);
      if (h == 0) SQ[rt * 4 + cc] = ss;
      __syncthreads();
      const f32x4 s4 = *(const LAS f32x4*)(SQ + rt * 4); const float r = 1.0f / sqrtf((s4[0] + s4[1] + s4[2] + s4[3]) * (1.0f / 128.f) + EPS_);
      const float* nw = c.mlstm_norm_w() + l * 512 + hh * 128 + 32 * cc + 4 * h; bf16_t* yp = c.Y() + (size_t)(m0 + rt) * DMIX + 1536 + hh * 128 + 32 * cc + 4 * h;
#pragma unroll
      for (int g = 0; g < 4; ++g) { const f32x4 wv = *(const f32x4*)(nw + 8 * g); u32x2 pk; pk.x = pk2(tot[4 * g] * r * wv[0], tot[4 * g + 1] * r * wv[1]); pk.y = pk2(tot[4 * g + 2] * r * wv[2], tot[4 * g + 3] * r * wv[3]); *(u32x2*)(yp + 8 * g) = pk; } }
    __syncthreads();
}

DEV float wmax64(float v) { v = fmaxf(v, fa::swz_xor<1>(v)); v = fmaxf(v, fa::swz_xor<2>(v)); v = fmaxf(v, fa::swz_xor<4>(v)); v = fmaxf(v, fa::swz_xor<8>(v)); v = fmaxf(v, fa::swz_xor<16>(v)); return fa::xhalf_max(v); }
DEV void mlstm_stream_unit(const Ctx& c, int l, LAS unsigned char* lds, const int tid, const int unit) {
    constexpr int QO = 0, KO = 16384, VO = 32768, KT = 49152, SO = 65536, WO = 98304, TBL = 107520;
    constexpr float SCALE = 0.08838834764831845f;
    const int lane = tid & 63, w = __builtin_amdgcn_readfirstlane(tid >> 6), r32 = lane & 31, h = lane >> 5;
    const int hh = unit & 3, b = (unit >> 2) & 3, dir = unit >> 4;
    LAS float* TB = (LAS float*)(lds + TBL); LAS float* TA = TB + 64; LAS float* TWI = TB + 128; LAS float* TEI = TB + 192; LAS float* QN = TB + 256; LAS float* NIN = TB + 320;
    const int srow = tid >> 4, sch = tid & 15; const unsigned soff = off_a(srow, sch);
    unsigned rb[2], nb[2]; rb[0] = row_base(lane, 0); rb[1] = row_base(lane, 1); nb[0] = nat_base(lane, 0); nb[1] = nat_base(lane, 1);
    const int dc = w >> 1, ec0 = (w & 1) * 2;
    const int cc = w >> 1, tb = w & 1, rt = 32 * tb + r32;
    f32x16 C0, C1;
#pragma unroll
    for (int i = 0; i < 16; ++i) { C0[i] = 0.f; C1[i] = 0.f; }
    float mm = 0.f;
    { const u32x4 z = {0u, 0u, 0u, 0u};
      for (int o = tid * 16; o < 32768; o += 8192) *(LAS u32x4*)(lds + SO + o) = z;
      if (tid < 128) NIN[tid] = 0.f; }
    bf16x8 gqA[2], gkA[2], gvA[2], gqB[2], gkB[2], gvB[2]; float gbA, gtaA, gpmA, gblA, gmlA, gbB, gtaB, gpmB, gblB, gmlB;
#define MS_LOAD(X, S_) do { const int ch_ = stream_chunk(dir, b, (S_)); \
        _Pragma("unroll") for (int i_ = 0; i_ < 2; ++i_) { const bf16_t* p_ = c.Pb() + (size_t)proc_row(dir, ch_, srow + 32 * i_) * NP + hh * 128 + sch * 8; \
            gq##X[i_] = *(const bf16x8*)(p_ + D_Q); gk##X[i_] = *(const bf16x8*)(p_ + D_K); gv##X[i_] = *(const bf16x8*)(p_ + D_V); } \
        const size_t o_ = ((size_t)dir * MT + proc_row(dir, ch_, lane)) * 4 + hh; gb##X = c.MB()[o_]; gta##X = c.MLI()[o_]; gpm##X = c.MWU()[o_]; \
        gbl##X = c.MBL()[((size_t)dir * NCH + ch_) * 4 + hh]; gml##X = c.MML()[((size_t)dir * NCH + ch_) * 4 + hh]; } while (0)
    MS_LOAD(A, 0); MS_LOAD(B, 1);
    const bf16x8 ones = {0x3F80, 0x3F80, 0x3F80, 0x3F80, 0x3F80, 0x3F80, 0x3F80, 0x3F80};
    f32x16 hold; bf16_t* hptr = (bf16_t*)c.MH();
#pragma unroll
    for (int i = 0; i < 16; ++i) hold[i] = 0.f;
#define MS_STEP(X, S_) do { const int s = (S_); \
        const int m0 = stream_chunk(dir, b, s) * 64; \
          \
        const float bj = gb##X, ta = gta##X, bl = gbl##X, mt = bj + fmaxf(mm, gpm##X), winter = fexp_(bj + mm - mt), mn = fmaxf(bl + mm, gml##X), ws = fexp_(bl + mm - mn), wu = fexp_(bl + ta - mn); \
          \
        _Pragma("unroll") \
        for (int i = 0; i < 2; ++i) { const float wr = fa::bperm(wu, srow + 32 * i); f32x4 x0, x1; \
            _Pragma("unroll") \
            for (int j = 0; j < 4; ++j) { x0[j] = wr * bfe(gk##X[i], j); x1[j] = wr * bfe(gk##X[i], 4 + j); } \
            *(LAS bf16x8*)(lds + QO + soff + 8192 * i) = gq##X[i]; *(LAS bf16x8*)(lds + KO + soff + 8192 * i) = gk##X[i]; *(LAS bf16x8*)(lds + VO + soff + 8192 * i) = gv##X[i]; *(LAS bf16x8*)(lds + KT + soff + 8192 * i) = pack8f(x0, x1); } \
        if (w == 0) { TB[lane] = bj - mt; TA[lane] = ta; TWI[lane] = winter; TEI[lane] = fexp_(-mt); } \
        if (s > 0) { \
            _Pragma("unroll") \
            for (int g = 0; g < 4; ++g) { u32x2 o4; o4.x = pk2(hold[4 * g], hold[4 * g + 1]); o4.y = pk2(hold[4 * g + 2], hold[4 * g + 3]); *(u32x2*)(hptr + 8 * g) = o4; } } \
        if (s + 2 < NSC) MS_LOAD(X, s + 2); \
        __syncthreads(); \
        if (w < 4) {                                \
            const int st = w >> 1, tt = w & 1, r0 = 32 * tt + r32; f32x16 p; \
            _Pragma("unroll") \
            for (int i = 0; i < 16; ++i) p[i] = 0.f; \
            _Pragma("unroll") \
            for (int hf = 0; hf < 2; ++hf) { bf16x8 ka[4], qa[4]; \
                _Pragma("unroll") \
                for (int k = 0; k < 4; ++k) { const int s8 = 4 * hf + k; ka[k] = *(const LAS bf16x8*)(lds + KO + 8192 * st + rb[s8 & 1] + 512 * (s8 >> 1)); qa[k] = *(const LAS bf16x8*)(lds + QO + 8192 * tt + rb[s8 & 1] + 512 * (s8 >> 1)); } \
                _Pragma("unroll") \
                for (int k = 0; k < 4; ++k) p = __builtin_amdgcn_mfma_f32_32x32x16_bf16(ka[k], qa[k], p, 0, 0, 0); } \
            const float bt = TB[r0]; \
            _Pragma("unroll") \
            for (int g = 0; g < 4; ++g) { const f32x4 tav = *(const LAS f32x4*)(TA + 32 * st + 8 * g + 4 * h); float wv[4]; \
                _Pragma("unroll") \
                for (int j = 0; j < 4; ++j) { const int rs = 32 * st + 8 * g + 4 * h + j; wv[j] = rs <= r0 ? fexp_(bt + tav[j]) * p[4 * g + j] * SCALE : 0.f; } \
                u32x2 pk; pk.x = pk2(wv[0], wv[1]); pk.y = pk2(wv[2], wv[3]); \
                *(LAS u32x2*)(lds + WO + r0 * 144 + (32 * st + 8 * g + 4 * h) * 2) = pk; } \
        } else {                                    \
            const int t = (tid - 256) >> 2, part = tid & 3; float sacc = 0.f; \
            _Pragma("unroll") \
            for (int k = 0; k < 4; ++k) { const bf16x8 qv = *(const LAS bf16x8*)(lds + QO + off_a(t & 31, 4 * part + k) + 8192 * (t >> 5)); \
                const f32x4 n0 = *(const LAS f32x4*)(NIN + 32 * part + 8 * k), n1 = *(const LAS f32x4*)(NIN + 32 * part + 8 * k + 4); \
                _Pragma("unroll") \
                for (int j = 0; j < 4; ++j) sacc += bfe(qv, j) * n0[j] + bfe(qv, 4 + j) * n1[j]; } \
            sacc += fa::swz_xor<1>(sacc); sacc += fa::swz_xor<2>(sacc); \
            if (part == 0) QN[t] = sacc * SCALE; \
        } \
        __syncthreads(); \
        {                                            \
          _Pragma("unroll") \
          for (int i = 0; i < 16; ++i) hold[i] = 0.f; \
          _Pragma("unroll") \
          for (int hf = 0; hf < 2; ++hf) { bf16x8 ca[4], qa[4]; \
              _Pragma("unroll") \
              for (int k = 0; k < 4; ++k) { const int s8 = 4 * hf + k; ca[k] = tr_frag(lds, SO + 8192 * (s8 >> 1) + 4096 * (s8 & 1) + 512 * cc, nb); qa[k] = *(const LAS bf16x8*)(lds + QO + 8192 * tb + rb[s8 & 1] + 512 * (s8 >> 1)); } \
              _Pragma("unroll") \
              for (int k = 0; k < 4; ++k) hold = __builtin_amdgcn_mfma_f32_32x32x16_bf16(ca[k], qa[k], hold, 0, 0, 0); } \
          bf16x8 wa[4], va[4]; \
          _Pragma("unroll") \
          for (int k4 = 0; k4 < 4; ++k4) { wa[k4] = *(const LAS bf16x8*)(lds + WO + rt * 144 + (16 * k4 + 8 * h) * 2); va[k4] = tr_frag(lds, VO + 8192 * (k4 >> 1) + 4096 * (k4 & 1) + 512 * cc, nb); } \
          const float wi = TWI[rt], wsq = wi * SCALE; \
          _Pragma("unroll") \
          for (int i = 0; i < 16; ++i) hold[i] *= wsq; \
          float rsum = 0.f; \
          _Pragma("unroll") \
          for (int k4 = 0; k4 < 4; ++k4) { \
              _Pragma("unroll") \
              for (int j = 0; j < 8; ++j) rsum += bfe(wa[k4], j); \
              hold = __builtin_amdgcn_mfma_f32_32x32x16_bf16(va[k4], wa[k4], hold, 0, 0, 0); } \
          rsum = xhalf_sum(rsum); \
          const float den = wi * QN[rt] + rsum, rinv = 1.0f / fmaxf(fabsf(den), TEI[rt]); \
          hptr = (bf16_t*)c.MH() + ((size_t)dir * MT + m0 + (dir ? 63 - rt : rt)) * 512 + hh * 128 + 32 * cc + 4 * h; \
          _Pragma("unroll") \
          for (int i = 0; i < 16; ++i) hold[i] *= rinv; } \
        __syncthreads(); \
        { f32x16 d2; bf16x8 bk[4], a0[4], a1[4];     \
          _Pragma("unroll") \
          for (int ks = 0; ks < 4; ++ks) { bk[ks] = tr_frag(lds, KT + 8192 * (ks >> 1) + 4096 * (ks & 1) + 512 * dc, nb); \
              a0[ks] = tr_frag(lds, VO + 8192 * (ks >> 1) + 4096 * (ks & 1) + 512 * ec0, nb); a1[ks] = tr_frag(lds, VO + 8192 * (ks >> 1) + 4096 * (ks & 1) + 512 * (ec0 + 1), nb); } \
          _Pragma("unroll") \
          for (int i = 0; i < 16; ++i) { C0[i] *= ws; C1[i] *= ws; d2[i] = 0.f; } \
          _Pragma("unroll") \
          for (int ks = 0; ks < 4; ++ks) { C0 = __builtin_amdgcn_mfma_f32_32x32x16_bf16(a0[ks], bk[ks], C0, 0, 0, 0); C1 = __builtin_amdgcn_mfma_f32_32x32x16_bf16(a1[ks], bk[ks], C1, 0, 0, 0); } \
          if (ec0 == 0) { \
              _Pragma("unroll") \
              for (int ks = 0; ks < 4; ++ks) d2 = __builtin_amdgcn_mfma_f32_32x32x16_bf16(ones, bk[ks], d2, 0, 0, 0); \
              if (h == 0) NIN[32 * dc + r32] = ws * NIN[32 * dc + r32] + d2[0]; } \
          _Pragma("unroll") \
          for (int g = 0; g < 4; ++g) { u32x2 pk; pk.x = pk2(C0[4 * g], C0[4 * g + 1]); pk.y = pk2(C0[4 * g + 2], C0[4 * g + 3]); *(LAS u32x2*)(lds + SO + 8192 * dc + off_a(r32, 4 * ec0 + g) + 8 * h) = pk; \
              pk.x = pk2(C1[4 * g], C1[4 * g + 1]); pk.y = pk2(C1[4 * g + 2], C1[4 * g + 3]); *(LAS u32x2*)(lds + SO + 8192 * dc + off_a(r32, 4 * (ec0 + 1) + g) + 8 * h) = pk; } \
          mm = mn; } \
        __syncthreads(); \
    } while (0)
    static_assert(NSC % 2 == 0, "the stream loop is unrolled by two");
    for (int s2 = 0; s2 < NSC; s2 += 2) { MS_STEP(A, s2); MS_STEP(B, s2 + 1); }
#pragma unroll
    for (int g = 0; g < 4; ++g) { u32x2 o4; o4.x = pk2(hold[4 * g], hold[4 * g + 1]); o4.y = pk2(hold[4 * g + 2], hold[4 * g + 3]); *(u32x2*)(hptr + 8 * g) = o4; }
#undef MS_STEP
#undef MS_LOAD
}
constexpr int N_ML_STREAMS = 2 * B_ * 4;

DEV void hgrn_stream_unit(const Ctx& c, LAS unsigned char* lds, const int tid, const int unit) {
    constexpr int QO = 0, VO = 16384, KT = 32768, SO = 49152;
    const int lane = tid & 63, w = __builtin_amdgcn_readfirstlane(tid >> 6), r32 = lane & 31, h = lane >> 5;
    const int hh = unit & 3, b = (unit >> 2) & 3, dir = unit >> 4;
    const int srow = tid >> 4, sch = tid & 15; const unsigned soff = off_a(srow, sch);
    unsigned rb[2], nb[2]; rb[0] = row_base(lane, 0); rb[1] = row_base(lane, 1); nb[0] = nat_base(lane, 0); nb[1] = nat_base(lane, 1);
    const int dc = w >> 1, ec0 = (w & 1) * 2;
    const int cc = w >> 1, tb = w & 1, rt = 32 * tb + r32;
    f32x16 C0, C1;
#pragma unroll
    for (int i = 0; i < 16; ++i) { C0[i] = 0.f; C1[i] = 0.f; }
    { const u32x4 z = {0u, 0u, 0u, 0u};
      for (int o = tid * 16; o < 32768; o += 8192) *(LAS u32x4*)(lds + SO + o) = z; }
    f32x4 gb[2][2], gl[2]; bf16x8 gqb[2], gkb[2], gv[2]; float gdec;
#define HS_LOAD(S_) do { const int ch_ = stream_chunk(dir, b, (S_)); \
        _Pragma("unroll") for (int i_ = 0; i_ < 2; ++i_) { const int m_ = proc_row(dir, ch_, srow + 32 * i_); const size_t og_ = (size_t)m_ * 512 + hh * 128 + sch * 8, od_ = (size_t)dir * MT * 512 + og_; \
            gqb[i_] = *(const bf16x8*)(c.Pb() + (size_t)m_ * NP + A_Q + hh * 128 + sch * 8); gb[i_][0] = *(const f32x4*)(c.BC() + od_); gb[i_][1] = *(const f32x4*)(c.BC() + od_ + 4); \
            gkb[i_] = *(const bf16x8*)((const bf16_t*)c.KK() + od_); gv[i_] = *(const bf16x8*)(c.Pb() + (size_t)m_ * NP + A_I + hh * 128 + sch * 8); } \
        const float* blp_ = c.BL() + ((size_t)dir * NCH + ch_) * 512 + hh * 128; gl[0] = *(const f32x4*)(blp_ + sch * 8); gl[1] = *(const f32x4*)(blp_ + sch * 8 + 4); gdec = blp_[32 * dc + r32]; } while (0)
    HS_LOAD(0);
    for (int s = 0; s < NSC; ++s) {
        const int m0 = stream_chunk(dir, b, s) * 64;
#pragma unroll
        for (int i = 0; i < 2; ++i) { f32x4 x0, x1, y0, y1;
#pragma unroll
            for (int j = 0; j < 4; ++j) { x0[j] = fsilu_(bfe(gqb[i], j)) * 0.08838834764831845f * fexp_(gb[i][0][j]); x1[j] = fsilu_(bfe(gqb[i], 4 + j)) * 0.08838834764831845f * fexp_(gb[i][1][j]);
                y0[j] = bfe(gkb[i], j) * fexp_(gl[0][j] - gb[i][0][j]); y1[j] = bfe(gkb[i], 4 + j) * fexp_(gl[1][j] - gb[i][1][j]); }
            *(LAS bf16x8*)(lds + QO + soff + 8192 * i) = pack8f(x0, x1); *(LAS bf16x8*)(lds + KT + soff + 8192 * i) = pack8f(y0, y1); *(LAS bf16x8*)(lds + VO + soff + 8192 * i) = gv[i]; }
        const float dec = fexp_(gdec);
        if (s + 1 < NSC) HS_LOAD(s + 1);
        __syncthreads();
        { f32x16 acc;
#pragma unroll
          for (int i = 0; i < 16; ++i) acc[i] = 0.f;
#pragma unroll
          for (int hf = 0; hf < 2; ++hf) { bf16x8 ca[4], qa[4];
#pragma unroll
              for (int k = 0; k < 4; ++k) { const int s8 = 4 * hf + k; ca[k] = tr_frag(lds, SO + 8192 * (s8 >> 1) + 4096 * (s8 & 1) + 512 * cc, nb); qa[k] = *(const LAS bf16x8*)(lds + QO + 8192 * tb + rb[s8 & 1] + 512 * (s8 >> 1)); }
#pragma unroll
              for (int k = 0; k < 4; ++k) acc = __builtin_amdgcn_mfma_f32_32x32x16_bf16(ca[k], qa[k], acc, 0, 0, 0); }
          bf16_t* hp = (bf16_t*)c.HO() + ((size_t)dir * MT + m0 + (dir ? 63 - rt : rt)) * 512 + hh * 128 + 32 * cc + 4 * h;
#pragma unroll
          for (int g = 0; g < 4; ++g) { u32x2 o4; o4.x = pk2(acc[4 * g], acc[4 * g + 1]); o4.y = pk2(acc[4 * g + 2], acc[4 * g + 3]); *(u32x2*)(hp + 8 * g) = o4; } }
        __syncthreads();
        { bf16x8 bk[4], a0[4], a1[4];
#pragma unroll
          for (int ks = 0; ks < 4; ++ks) { bk[ks] = tr_frag(lds, KT + 8192 * (ks >> 1) + 4096 * (ks & 1) + 512 * dc, nb);
              a0[ks] = tr_frag(lds, VO + 8192 * (ks >> 1) + 4096 * (ks & 1) + 512 * ec0, nb); a1[ks] = tr_frag(lds, VO + 8192 * (ks >> 1) + 4096 * (ks & 1) + 512 * (ec0 + 1), nb); }
#pragma unroll
          for (int i = 0; i < 16; ++i) { C0[i] *= dec; C1[i] *= dec; }
#pragma unroll
          for (int ks = 0; ks < 4; ++ks) { C0 = __builtin_amdgcn_mfma_f32_32x32x16_bf16(a0[ks], bk[ks], C0, 0, 0, 0); C1 = __builtin_amdgcn_mfma_f32_32x32x16_bf16(a1[ks], bk[ks], C1, 0, 0, 0); }
#pragma unroll
          for (int g = 0; g < 4; ++g) { u32x2 pk; pk.x = pk2(C0[4 * g], C0[4 * g + 1]); pk.y = pk2(C0[4 * g + 2], C0[4 * g + 3]); *(LAS u32x2*)(lds + SO + 8192 * dc + off_a(r32, 4 * ec0 + g) + 8 * h) = pk;
              pk.x = pk2(C1[4 * g], C1[4 * g + 1]); pk.y = pk2(C1[4 * g + 2], C1[4 * g + 3]); *(LAS u32x2*)(lds + SO + 8192 * dc + off_a(r32, 4 * (ec0 + 1) + g) + 8 * h) = pk; } }
        __syncthreads();
    }
#undef HS_LOAD
}
constexpr int N_HG_STREAMS = 2 * B_ * 4;

DEV void hgrn_out2_unit(const Ctx& c, int l, LAS unsigned char* lds, const int tid, const int unit) {
    constexpr int QO = 0, VO = 16384, SO = 32768, WO = 65536, QT = 74752, KS = QT + 9216, BT = KS + 9216, OP = 102400, Q1 = OP, K1 = OP + 2560, Q2 = OP + 5120, K2 = OP + 7680;
    const int lane = tid & 63, w = __builtin_amdgcn_readfirstlane(tid >> 6), r32 = lane & 31, h = lane >> 5;
    const int hh = unit & 3, chunk = unit >> 2, m0 = chunk * 64;
    const int cc = w >> 1, tb = w & 1, rt = 32 * tb + r32; f32x16 tot;
#pragma unroll
    for (int i = 0; i < 16; ++i) tot[i] = 0.f;
    for (int dir = 0; dir < 2; ++dir) {
    const int uo = (dir * NCH + chunk) * 4 + hh;
    { const int srow = tid >> 4, sch = tid & 15; const unsigned soff = off_a(srow, sch);
#pragma unroll
      for (int i = 0; i < 2; ++i) { const int jr = srow + 32 * i, m = m0 + (dir ? 63 - jr : jr); *(LAS bf16x8*)(lds + VO + soff + 8192 * i) = *(const bf16x8*)(c.Pb() + (size_t)m * NP + A_I + hh * 128 + sch * 8); }
      const u32x4 z = {0u, 0u, 0u, 0u};
      for (int o = tid * 16; o < 9216; o += 8192) *(LAS u32x4*)(lds + WO + o) = z; }
    f32x16 accL;
#pragma unroll
    for (int i = 0; i < 16; ++i) accL[i] = 0.f;
    float ad0 = 0.f, ad1 = 0.f;
    const int db = w >> 1, qi = 64 * (w & 1) + lane, rp = qi >> 4, ci = qi & 15; int tl, sl; const bool two = rp == 7 && ci >= 8;
    if (rp < 7) { const bool sm = ci < rp + 1; tl = sm ? rp + 1 : 15 - rp; sl = sm ? ci : ci - (rp + 1); } else if (ci < 8) { tl = 8; sl = ci; } else { tl = 2 * (ci - 8); sl = tl; }
    const int dt = 16 * db + tl, ds0 = 16 * db + sl;
    const int prow = tid >> 3, pd4 = tid & 7, mrow = m0 + (dir ? 63 - prow : prow);
    const size_t og0 = (size_t)mrow * 512 + hh * 128 + pd4 * 4, od0 = (size_t)dir * MT * 512 + og0;
    const bf16_t* qsrc = c.Pb() + (size_t)mrow * NP + A_Q + hh * 128 + pd4 * 4; const bf16_t* ksrc = (const bf16_t*)c.KK() + od0;
#define HG_QK(DQ_) do { const u32x2 qr_ = *(const u32x2*)(qsrc + (DQ_) * 32), kr_ = *(const u32x2*)(ksrc + (DQ_) * 32); \
        gq = (f32x4){fsilu_(__builtin_bit_cast(float, qr_.x << 16)), fsilu_(__builtin_bit_cast(float, qr_.x & 0xffff0000u)), fsilu_(__builtin_bit_cast(float, qr_.y << 16)), fsilu_(__builtin_bit_cast(float, qr_.y & 0xffff0000u))} * 0.08838834764831845f; \
        gk = (f32x4){__builtin_bit_cast(float, kr_.x << 16), __builtin_bit_cast(float, kr_.x & 0xffff0000u), __builtin_bit_cast(float, kr_.y << 16), __builtin_bit_cast(float, kr_.y & 0xffff0000u)}; } while (0)
    f32x4 gq, gk, gb = *(const f32x4*)(c.BC() + od0); HG_QK(0);
    for (int dq = 0; dq < 4; ++dq) {
        const f32x4 b2 = gb * fa::LOG2E;
        *(LAS f32x4*)(lds + QT + (prow * 36 + pd4 * 4) * 4) = gq; *(LAS f32x4*)(lds + KS + (prow * 36 + pd4 * 4) * 4) = gk; *(LAS f32x4*)(lds + BT + (prow * 36 + pd4 * 4) * 4) = b2;
        __syncthreads();
        const f32x4 cq = gq, ck = gk;
        if (dq < 3) { HG_QK(dq + 1); gb = *(const f32x4*)(c.BC() + od0 + (dq + 1) * 32); }
        { const f32x4 r15 = *(const LAS f32x4*)(lds + BT + (15 * 36 + pd4 * 4) * 4), r31 = *(const LAS f32x4*)(lds + BT + (31 * 36 + pd4 * 4) * 4), r47 = *(const LAS f32x4*)(lds + BT + (47 * 36 + pd4 * 4) * 4);
#define HG_PUT(TILE, ROWL, VAL, EXPO) do { u32x2 pk_; pk_.x = pk2((VAL)[0] * __builtin_amdgcn_exp2f((EXPO)[0]), (VAL)[1] * __builtin_amdgcn_exp2f((EXPO)[1])); \
            pk_.y = pk2((VAL)[2] * __builtin_amdgcn_exp2f((EXPO)[2]), (VAL)[3] * __builtin_amdgcn_exp2f((EXPO)[3])); *(LAS u32x2*)(lds + (TILE) + (ROWL) * 80 + pd4 * 8) = pk_; } while (0)
          if (prow >= 32) { const f32x4 e = b2 - r31; HG_PUT(Q1, prow - 32, cq, e); } else { const f32x4 e = r31 - b2; HG_PUT(K1, prow, ck, e); }
          if (prow >= 48) { const f32x4 e = b2 - r47; HG_PUT(Q2, prow - 32, cq, e); } else if (prow >= 32) { const f32x4 e = r47 - b2; HG_PUT(K2, prow - 16, ck, e); }
          else if (prow >= 16) { const f32x4 e = b2 - r15; HG_PUT(Q2, prow - 16, cq, e); } else { const f32x4 e = r15 - b2; HG_PUT(K2, prow, ck, e); }
#undef HG_PUT
        }
#pragma unroll 2
        for (int d4 = 0; d4 < 8; ++d4) { const f32x4 qt = *(const LAS f32x4*)(lds + QT + (dt * 36 + d4 * 4) * 4), bt = *(const LAS f32x4*)(lds + BT + (dt * 36 + d4 * 4) * 4);
            const f32x4 k0 = *(const LAS f32x4*)(lds + KS + (ds0 * 36 + d4 * 4) * 4), b0 = *(const LAS f32x4*)(lds + BT + (ds0 * 36 + d4 * 4) * 4);
#pragma unroll
            for (int e = 0; e < 4; ++e) ad0 += qt[e] * k0[e] * __builtin_amdgcn_exp2f(bt[e] - b0[e]); }
        if (two) {
#pragma unroll 2
            for (int d4 = 0; d4 < 8; ++d4) { const f32x4 q1 = *(const LAS f32x4*)(lds + QT + ((dt + 1) * 36 + d4 * 4) * 4), k1 = *(const LAS f32x4*)(lds + KS + ((dt + 1) * 36 + d4 * 4) * 4);
#pragma unroll
                for (int e = 0; e < 4; ++e) ad1 += q1[e] * k1[e]; } }
        __syncthreads();
        if (w < 2) { const int qo = w == 0 ? Q1 : Q2, ko = w == 0 ? K1 : K2;
#pragma unroll
            for (int ks = 0; ks < 2; ++ks) { const bf16x8 a = *(const LAS bf16x8*)(lds + ko + r32 * 80 + (16 * ks + 8 * h) * 2), b = *(const LAS bf16x8*)(lds + qo + r32 * 80 + (16 * ks + 8 * h) * 2);
                accL = __builtin_amdgcn_mfma_f32_32x32x16_bf16(a, b, accL, 0, 0, 0); } }
    }
    if (w == 0) { const int t = 32 + r32;
#pragma unroll
        for (int g = 0; g < 4; ++g) { u32x2 pk; pk.x = pk2(accL[4 * g], accL[4 * g + 1]); pk.y = pk2(accL[4 * g + 2], accL[4 * g + 3]); *(LAS u32x2*)(lds + WO + t * 144 + (8 * g + 4 * h) * 2) = pk; } }
    else if (w == 1) { const bool lo = r32 < 16; const int t = lo ? 16 + r32 : 32 + r32;
#pragma unroll
        for (int g = 0; g < 4; ++g) { const bool mine = lo ? g < 2 : g >= 2; const int s = (lo ? 0 : 16) + 8 * g + 4 * h;
            if (mine) { u32x2 pk; pk.x = pk2(accL[4 * g], accL[4 * g + 1]); pk.y = pk2(accL[4 * g + 2], accL[4 * g + 3]); *(LAS u32x2*)(lds + WO + t * 144 + s * 2) = pk; } } }
    *(LAS bf16_t*)(lds + WO + dt * 144 + ds0 * 2) = f2bf(ad0);
    if (two) *(LAS bf16_t*)(lds + WO + (dt + 1) * 144 + (dt + 1) * 2) = f2bf(ad1);
    __syncthreads();
    { unsigned nb[2]; nb[0] = nat_base(lane, 0); nb[1] = nat_base(lane, 1);
      const int jrow = dir ? 63 - rt : rt;
#pragma unroll
      for (int k4 = 0; k4 < 4; ++k4) { const bf16x8 b = *(const LAS bf16x8*)(lds + WO + jrow * 144 + (16 * k4 + 8 * h) * 2);
          const bf16x8 av = tr_frag(lds, VO + 8192 * (k4 >> 1) + 4096 * (k4 & 1) + 512 * cc, nb);
          tot = __builtin_amdgcn_mfma_f32_32x32x16_bf16(av, b, tot, 0, 0, 0); } }
    __syncthreads();
    }
    { bf16_t* hi = (bf16_t*)c.HST() + (size_t)(m0 + rt) * 512 + hh * 128 + 32 * cc + 4 * h;
#pragma unroll
      for (int g = 0; g < 4; ++g) { u32x2 o4; o4.x = pk2(tot[4 * g], tot[4 * g + 1]); o4.y = pk2(tot[4 * g + 2], tot[4 * g + 3]); *(u32x2*)(hi + 8 * g) = o4; } }
    __syncthreads();
}
constexpr int N_CH_UNITS = 2 * NCH * 4, N_CH2_UNITS = NCH * 4;
}
namespace thin {
using fa::pk2; using fa::u32x2; using fa::u32x4; using fa::bf16x8; using ch::f32x4; using ch::bfe;
DEV float wave_sum(float v) { v += fa::swz_xor<1>(v); v += fa::swz_xor<2>(v); v += fa::swz_xor<4>(v); v += fa::swz_xor<8>(v); v += fa::swz_xor<16>(v); return fa::xhalf_sum(v); }
DEV float wave_max(float v) { v = fmaxf(v, fa::swz_xor<1>(v)); v = fmaxf(v, fa::swz_xor<2>(v)); v = fmaxf(v, fa::swz_xor<4>(v)); v = fmaxf(v, fa::swz_xor<8>(v)); v = fmaxf(v, fa::swz_xor<16>(v)); return fa::xhalf_max(v); }
static_assert(D_ == 2048, "row stages are written for d_model 2048");

DEV void unpack8(const u32x4 r, f32x4& a, f32x4& b) {
    a = (f32x4){__builtin_bit_cast(float, r.x << 16), __builtin_bit_cast(float, r.x & 0xffff0000u), __builtin_bit_cast(float, r.y << 16), __builtin_bit_cast(float, r.y & 0xffff0000u)};
    b = (f32x4){__builtin_bit_cast(float, r.z << 16), __builtin_bit_cast(float, r.z & 0xffff0000u), __builtin_bit_cast(float, r.w << 16), __builtin_bit_cast(float, r.w & 0xffff0000u)}; }
DEV u32x4 pack8v(const f32x4 a, const f32x4 b) { u32x4 p; p.x = pk2(a[0], a[1]); p.y = pk2(a[2], a[3]); p.z = pk2(b[0], b[1]); p.w = pk2(b[2], b[3]); return p; }
template <int NR>
DEV void mod_row(const Ctx& c, int l, int which, int m0, int lane, int np, const float* pg) {
    bf16_t* x = c.XB() + (size_t)m0 * D_ + 8 * lane; f32x4 v[NR][4][2];
    if (l == 0 && which == 0) {
        const float* xi = (m0 < MX ? c.x_in() + (size_t)m0 * D_ : c.ctx_in() + (size_t)(m0 - MX) * D_) + 8 * lane;
#pragma unroll
        for (int r = 0; r < NR; ++r)
#pragma unroll
            for (int i = 0; i < 4; ++i) { v[r][i][0] = *(const f32x4*)(xi + r * D_ + 512 * i); v[r][i][1] = *(const f32x4*)(xi + r * D_ + 512 * i + 4); if (m0 >= MX) *(u32x4*)(x + r * D_ + 512 * i) = pack8v(v[r][i][0], v[r][i][1]); }
    } else {
#pragma unroll
        for (int r = 0; r < NR; ++r)
#pragma unroll
            for (int i = 0; i < 4; ++i) unpack8(*(const u32x4*)(x + r * D_ + 512 * i), v[r][i][0], v[r][i][1]);
    }
    if (m0 >= MX && np > 0) { const bf16_t* pp = (const bf16_t*)c.PARTS() + (size_t)(m0 - MX) * D_ + 8 * lane;
#pragma unroll
        for (int r = 0; r < NR; ++r)
#pragma unroll
            for (int i = 0; i < 4; ++i) { f32x4 s0, s1; unpack8(*(const u32x4*)(pp + r * D_ + 512 * i), s0, s1);
                for (int k = 1; k < np; ++k) { f32x4 t0, t1; unpack8(*(const u32x4*)(pp + (size_t)k * MCX * D_ + r * D_ + 512 * i), t0, t1); s0 = s0 + t0; s1 = s1 + t1; }
                v[r][i][0] = v[r][i][0] + *(const f32x4*)(pg + 8 * lane + 512 * i) * s0; v[r][i][1] = v[r][i][1] + *(const f32x4*)(pg + 8 * lane + 512 * i + 4) * s1;
                *(u32x4*)(x + r * D_ + 512 * i) = pack8v(v[r][i][0], v[r][i][1]); } }
    const float* md = c.MOD() + ((size_t)l * NV + row_vec(m0)) * D6 + which * 3 * D_ + 8 * lane;
#pragma unroll
    for (int r = 0; r < NR; ++r) { float ss = 0.f;
#pragma unroll
        for (int i = 0; i < 4; ++i)
#pragma unroll
            for (int q = 0; q < 2; ++q) ss += v[r][i][q][0] * v[r][i][q][0] + v[r][i][q][1] * v[r][i][q][1] + v[r][i][q][2] * v[r][i][q][2] + v[r][i][q][3] * v[r][i][q][3];
        ss = wave_sum(ss); const float rr = 1.0f / sqrtf(ss * (1.0f / D_) + EPS_); bf16_t* hp = c.Hb() + (size_t)(m0 + r) * D_ + 8 * lane;
#pragma unroll
        for (int i = 0; i < 4; ++i) { const f32x4 sh0 = *(const f32x4*)(md + 512 * i), sh1 = *(const f32x4*)(md + 512 * i + 4), sc0 = *(const f32x4*)(md + D_ + 512 * i), sc1 = *(const f32x4*)(md + D_ + 512 * i + 4);
            *(u32x4*)(hp + 512 * i) = pack8v(v[r][i][0] * rr * (sc0 + 1.0f) + sh0, v[r][i][1] * rr * (sc1 + 1.0f) + sh1); } }
}
template <int INL>
DEV void modp4(const Ctx& c, long i) {
    constexpr int C4 = D6 / 4, KL = D_ / KPARTS; const int c4 = (int)(i % C4), kp = (int)((i / C4) % KPARTS), l = (int)(i / ((long)C4 * KPARTS)), col = c4 * 4;
    f32x4 acc[NV];
#pragma unroll
    for (int v = 0; v < NV; ++v) acc[v] = (f32x4){0.f, 0.f, 0.f, 0.f};
    const float* wp = c.w_ada() + ((size_t)l * D_ + kp * KL) * D6 + col; const float* sp = c.SC() + kp * KL;
    for (int k = 0; k < KL; k += 8) { f32x4 w[8];
#pragma unroll
        for (int j = 0; j < 8; ++j) w[j] = *(const f32x4*)(wp + (size_t)(k + j) * D6);
#pragma unroll
        for (int j = 0; j < 8; ++j)
#pragma unroll
            for (int v = 0; v < NV; ++v) { const float sv = INL ? fsilu_(v < B_ ? c.c_in()[v * D_ + kp * KL + k + j] : c.c_ctx()[kp * KL + k + j]) : sp[v * D_ + k + j]; acc[v] = acc[v] + w[j] * sv; } }
#pragma unroll
    for (int v = 0; v < NV; ++v) *(f32x4*)(c.MODP() + (((size_t)l * KPARTS + kp) * NV + v) * D6 + col) = acc[v];
}
DEV void final_row(const Ctx& c, int p, int lane) {
    constexpr int NR = 4; const bf16_t* x = c.XB() + (size_t)(NR * p) * D_ + 8 * lane; f32x4 v[NR][4][2];
#pragma unroll
    for (int r = 0; r < NR; ++r)
#pragma unroll
        for (int i = 0; i < 4; ++i) unpack8(*(const u32x4*)(x + r * D_ + 512 * i), v[r][i][0], v[r][i][1]);
#pragma unroll
    for (int r = 0; r < NR; ++r) { float ss = 0.f;
#pragma unroll
        for (int i = 0; i < 4; ++i)
#pragma unroll
            for (int q = 0; q < 2; ++q) ss += v[r][i][q][0] * v[r][i][q][0] + v[r][i][q][1] * v[r][i][q][1] + v[r][i][q][2] * v[r][i][q][2] + v[r][i][q][3] * v[r][i][q][3];
        ss = wave_sum(ss); const float rr = 1.0f / sqrtf(ss * (1.0f / D_) + EPS_);
#pragma unroll
        for (int i = 0; i < 4; ++i)
#pragma unroll
            for (int q = 0; q < 2; ++q) { const f32x4 w = *(const f32x4*)(c.final_norm_w() + 8 * lane + 512 * i + 4 * q); *(f32x4*)(c.out() + (size_t)(NR * p + r) * D_ + 8 * lane + 512 * i + 4 * q) = v[r][i][q] * rr * w; } }
}
DEV void hgrn_gate(const Ctx& c, int l, long it, int lane) {
    const int hh = (int)(it & 3), m = (int)(it >> 2); const size_t o = (size_t)m * 512 + hh * 128 + 2 * lane;
    const float2 a = *(const float2*)(c.HO() + o), b = *(const float2*)(c.HO() + (size_t)MT * 512 + o); const float o0 = a.x + b.x, o1 = a.y + b.y;
    const float ss = wave_sum(o0 * o0 + o1 * o1), r = 1.0f / sqrtf(ss * (1.0f / 128.f) + EPS_);
    const float2 w = *(const float2*)(c.hgrn_norm_w() + l * 512 + hh * 128 + 2 * lane); const unsigned gg = *(const unsigned*)(c.Pb() + (size_t)m * NP + A_G + hh * 128 + 2 * lane);
    const float g0 = bf2f((bf16_t)(gg & 0xffffu)), g1 = bf2f((bf16_t)(gg >> 16));
    *(unsigned*)(c.Y() + (size_t)m * DMIX + hh * 128 + 2 * lane) = pk2(o0 * r * w.x * fsilu_(g0), o1 * r * w.y * fsilu_(g1));
}
DEV void mlstm_gate(const Ctx& c, int l, long it, int lane) {
    const int hh = (int)(it & 3), m = (int)(it >> 2); const size_t o = (size_t)m * 512 + hh * 128 + 2 * lane;
    const float2 a = *(const float2*)(c.MH() + o), b = *(const float2*)(c.MH() + (size_t)MT * 512 + o);
    const unsigned gg = *(const unsigned*)(c.Pb() + (size_t)m * NP + D_O + hh * 128 + 2 * lane);
    const float v0 = fsig_(bf2f((bf16_t)(gg & 0xffffu))) * (a.x + b.x), v1 = fsig_(bf2f((bf16_t)(gg >> 16))) * (a.y + b.y);
    const float ss = wave_sum(v0 * v0 + v1 * v1), r = 1.0f / sqrtf(ss * (1.0f / 128.f) + EPS_);
    const float2 w = *(const float2*)(c.mlstm_norm_w() + l * 512 + hh * 128 + 2 * lane);
    *(unsigned*)(c.Y() + (size_t)m * DMIX + 1536 + hh * 128 + 2 * lane) = pk2(v0 * r * w.x, v1 * r * w.y);
}
DEV void post8(const Ctx& c, int l, long i) {
    const int c8 = (int)(i & 15), hh = (int)((i >> 4) & 3), m = (int)(i >> 6); const size_t o = (size_t)m * 512 + hh * 128 + c8 * 8;
    const u32x4 ra = *(const u32x4*)((const bf16_t*)c.HO() + o), rb = *(const u32x4*)((const bf16_t*)c.HO() + (size_t)MT * 512 + o), ri = *(const u32x4*)((const bf16_t*)c.HST() + o);
    const u32x4 sa = *(const u32x4*)((const bf16_t*)c.MH() + o), sb = *(const u32x4*)((const bf16_t*)c.MH() + (size_t)MT * 512 + o);
    const bf16x8 gh = *(const bf16x8*)(c.Pb() + (size_t)m * NP + A_G + hh * 128 + c8 * 8), gm = *(const bf16x8*)(c.Pb() + (size_t)m * NP + D_O + hh * 128 + c8 * 8);
    { f32x4 a0, a1, b0, b1, i0, i1; unpack8(ra, a0, a1); unpack8(rb, b0, b1); unpack8(ri, i0, i1);
      float v[8], ss = 0.f;
#pragma unroll
      for (int j = 0; j < 4; ++j) { v[j] = a0[j] + b0[j] + i0[j]; v[4 + j] = a1[j] + b1[j] + i1[j]; ss += v[j] * v[j] + v[4 + j] * v[4 + j]; }
      ss += fa::swz_xor<1>(ss); ss += fa::swz_xor<2>(ss); ss += fa::swz_xor<4>(ss); ss += fa::swz_xor<8>(ss);
      const float r = 1.0f / sqrtf(ss * (1.0f / 128.f) + EPS_);
      const float* nw = c.hgrn_norm_w() + l * 512 + hh * 128 + c8 * 8; const f32x4 w0 = *(const f32x4*)nw, w1 = *(const f32x4*)(nw + 4);
      u32x4 pk; pk.x = pk2(v[0] * r * w0[0] * fsilu_(bfe(gh, 0)), v[1] * r * w0[1] * fsilu_(bfe(gh, 1))); pk.y = pk2(v[2] * r * w0[2] * fsilu_(bfe(gh, 2)), v[3] * r * w0[3] * fsilu_(bfe(gh, 3)));
      pk.z = pk2(v[4] * r * w1[0] * fsilu_(bfe(gh, 4)), v[5] * r * w1[1] * fsilu_(bfe(gh, 5))); pk.w = pk2(v[6] * r * w1[2] * fsilu_(bfe(gh, 6)), v[7] * r * w1[3] * fsilu_(bfe(gh, 7)));
      *(u32x4*)(c.Y() + (size_t)m * DMIX + hh * 128 + c8 * 8) = pk; }
    { f32x4 a0, a1, b0, b1; unpack8(sa, a0, a1); unpack8(sb, b0, b1);
      float v[8], ss = 0.f;
#pragma unroll
      for (int j = 0; j < 4; ++j) { v[j] = fsig_(bfe(gm, j)) * (a0[j] + b0[j]); v[4 + j] = fsig_(bfe(gm, 4 + j)) * (a1[j] + b1[j]); ss += v[j] * v[j] + v[4 + j] * v[4 + j]; }
      ss += fa::swz_xor<1>(ss); ss += fa::swz_xor<2>(ss); ss += fa::swz_xor<4>(ss); ss += fa::swz_xor<8>(ss);
      const float r = 1.0f / sqrtf(ss * (1.0f / 128.f) + EPS_);
      const float* nw = c.mlstm_norm_w() + l * 512 + hh * 128 + c8 * 8; const f32x4 w0 = *(const f32x4*)nw, w1 = *(const f32x4*)(nw + 4);
      u32x4 pk; pk.x = pk2(v[0] * r * w0[0], v[1] * r * w0[1]); pk.y = pk2(v[2] * r * w0[2], v[3] * r * w0[3]); pk.z = pk2(v[4] * r * w1[0], v[5] * r * w1[1]); pk.w = pk2(v[6] * r * w1[2], v[7] * r * w1[3]);
      *(u32x4*)(c.Y() + (size_t)m * DMIX + 1536 + hh * 128 + c8 * 8) = pk; }
}
DEV void mlstm_gates(const Ctx& c, int l, long it, int lane) {
    const int hh = (int)(it & 3), chunk = (int)((it >> 2) % NCH), dir = (int)((it >> 2) / NCH); const int m = proc_row(dir, chunk, lane);
    const float* g = c.G() + (size_t)m * 16; const float li = g[(2 * dir) * 4 + hh]; const float zf = g[(2 * dir + 1) * 4 + hh] + c.mlstm_f_bias()[(l * 2 + dir) * 4 + hh]; float v = fminf(zf, 0.f) - flog_(1.0f + fexp_(-fabsf(zf)));
#pragma unroll
    for (int o = 1; o < 64; o <<= 1) { const float t = fa::bperm(v, lane - o); if (lane >= o) v += t; }
    const float bl = fa::bperm(v, 63), ta = li - v, ml = wave_max(bl + ta); float pm = ta;
#pragma unroll
    for (int o = 1; o < 64; o <<= 1) { const float t = fa::bperm(pm, lane - o); if (lane >= o) pm = fmaxf(pm, t); }
    const size_t o = ((size_t)dir * MT + m) * 4 + hh; c.MB()[o] = v; c.MLI()[o] = ta; c.MWU()[o] = pm;
    if (lane == 0) { c.MBL()[((size_t)dir * NCH + chunk) * 4 + hh] = bl; c.MML()[((size_t)dir * NCH + chunk) * 4 + hh] = ml; }
}
DEV void hgrn_prep8(const Ctx& c, int l, long i) {
    const int c8 = (int)(i & 63), m = (int)(i >> 6), col = c8 * 8; const bf16_t* p = c.Pb() + (size_t)m * NP + col;
    const bf16x8 q = *(const bf16x8*)(p + A_Q); f32x4 q0, q1;
#pragma unroll
    for (int j = 0; j < 4; ++j) { q0[j] = fsilu_(bfe(q, j)) * 0.08838834764831845f; q1[j] = fsilu_(bfe(q, 4 + j)) * 0.08838834764831845f; }
    *(f32x4*)(c.QH() + (size_t)m * 512 + col) = q0; *(f32x4*)(c.QH() + (size_t)m * 512 + col + 4) = q1;
#pragma unroll
    for (int dir = 0; dir < 2; ++dir) { const bf16x8 z = *(const bf16x8*)(p + A_ZF + dir * 512); const float* lb = c.LBV() + (l * 2 + dir) * 512 + col; f32x4 k0, k1, b0, b1;
#pragma unroll
        for (int j = 0; j < 4; ++j) { k0[j] = (1.0f - lb[j]) * fsig_(-bfe(z, j)); k1[j] = (1.0f - lb[4 + j]) * fsig_(-bfe(z, 4 + j)); b0[j] = log1pf(-k0[j]); b1[j] = log1pf(-k1[j]); }
        const size_t o = ((size_t)dir * MT + m) * 512 + col;
        *(f32x4*)(c.KK() + o) = k0; *(f32x4*)(c.KK() + o + 4) = k1; *(f32x4*)(c.BC() + o) = b0; *(f32x4*)(c.BC() + o + 4) = b1; }
}
DEV void hgrn_decay_scan(const Ctx& c, int l, long i) {
    const int col = (int)(i % 512), chunk = (int)((i / 512) % NCH), dir = (int)(i / (512L * NCH)); const float lb0 = c.LBV()[(l * 2 + dir) * 512 + col], lb1 = 1.0f - lb0; float s = 0.f;
    const bf16_t* zp = c.Pb() + (size_t)chunk * 64 * NP + A_ZF + dir * 512 + col; const size_t ob = ((size_t)dir * MT + chunk * 64) * 512 + col;
    bf16_t z[64];
#pragma unroll
    for (int j = 0; j < 64; ++j) { const int r = dir ? 63 - j : j; z[j] = zp[(size_t)r * NP]; }
    { constexpr int jb = 0;
#pragma unroll
        for (int j = 0; j < 64; ++j) { const int r = dir ? 63 - (jb + j) : jb + j; const float zz = bf2f(z[j]), kk = lb1 * fsig_(-zz); s += flog_(lb0 + lb1 * fsig_(zz));        ((bf16_t*)c.KK())[ob + (size_t)r * 512] = f2bf(kk); c.BC()[ob + (size_t)r * 512] = s; } }
    c.BL()[((size_t)dir * NCH + chunk) * 512 + col] = s;
}
DEV void hgrn_q8(const Ctx& c, long i) {
    const int c8 = (int)(i & 63), m = (int)(i >> 6), col = c8 * 8; const bf16x8 q = *(const bf16x8*)(c.Pb() + (size_t)m * NP + A_Q + col); f32x4 q0, q1;
#pragma unroll
    for (int j = 0; j < 4; ++j) { q0[j] = fsilu_(bfe(q, j)) * 0.08838834764831845f; q1[j] = fsilu_(bfe(q, 4 + j)) * 0.08838834764831845f; }
    *(f32x4*)(c.QH() + (size_t)m * 512 + col) = q0; *(f32x4*)(c.QH() + (size_t)m * 512 + col + 4) = q1;
}
constexpr int CONV_J8 = FF_ / 8, CONV_STRIPS = (256 * 512) / CONV_J8;
DEV void conv_strip(const Ctx& c, int l, long i, int mrows) {
    const int j8 = (int)(i % CONV_J8), strip = (int)(i / CONV_J8), col = j8 * 8;
    float wa[3][8], wg[3][8], ba[8], bg[8];
#pragma unroll
    for (int t = 0; t < 3; ++t)
#pragma unroll
        for (int h2 = 0; h2 < 2; ++h2) { const f32x4 a = *(const f32x4*)(c.conv_w() + ((size_t)l * 3 + t) * FF2 + col + h2 * 4), g = *(const f32x4*)(c.conv_w() + ((size_t)l * 3 + t) * FF2 + FF_ + col + h2 * 4);
#pragma unroll
            for (int j = 0; j < 4; ++j) { wa[t][h2 * 4 + j] = a[j]; wg[t][h2 * 4 + j] = g[j]; } }
#pragma unroll
    for (int h2 = 0; h2 < 2; ++h2) { const f32x4 a = *(const f32x4*)(c.conv_b() + (size_t)l * FF2 + col + h2 * 4), g = *(const f32x4*)(c.conv_b() + (size_t)l * FF2 + FF_ + col + h2 * 4);
#pragma unroll
        for (int j = 0; j < 4; ++j) { ba[h2 * 4 + j] = a[j]; bg[h2 * 4 + j] = g[j]; } }
    const bf16x8 zero = {0, 0, 0, 0, 0, 0, 0, 0};
    for (int rb = strip; rb < mrows / 4; rb += CONV_STRIPS) {
        const int m0 = rb * 4, pos0 = row_pos(m0), len = row_len(m0);
        bf16x8 ua[6], ug[6];
#pragma unroll
        for (int r = 0; r < 6; ++r) { const bool ok = pos0 + r - 1 >= 0 && pos0 + r - 1 < len; const bf16_t* up = c.U() + (size_t)(m0 + r - 1) * FF2 + col;
            ua[r] = ok ? *(const bf16x8*)up : zero; ug[r] = ok ? *(const bf16x8*)(up + FF_) : zero; }
#pragma unroll
        for (int r = 0; r < 4; ++r) { float o[8];
#pragma unroll
            for (int j = 0; j < 8; ++j) { const float a = ba[j] + wa[0][j] * bfe(ua[r], j) + wa[1][j] * bfe(ua[r + 1], j) + wa[2][j] * bfe(ua[r + 2], j), g = bg[j] + wg[0][j] * bfe(ug[r], j) + wg[1][j] * bfe(ug[r + 1], j) + wg[2][j] * bfe(ug[r + 2], j); o[j] = fsilu_(a) * g; }
            u32x4 pk; pk.x = pk2(o[0], o[1]); pk.y = pk2(o[2], o[3]); pk.z = pk2(o[4], o[5]); pk.w = pk2(o[6], o[7]);
            *(u32x4*)(c.ACT() + (size_t)(m0 + r) * FF_ + col) = pk; } }
}
DEV void rope16(const Ctx& c, long i) {
    const int half = (int)(i & 1), blk = (int)((i >> 1) & 7), which = (int)((i >> 4) & 1), m = (int)(i >> 5); const int base = which * 512 + blk * 64 + half * 32;
    const bf16_t* p = c.Pb() + (size_t)m * NP + B_Q + base; bf16_t* q = c.QKB() + (size_t)m * 1024 + base;
    const bf16x8 a0 = *(const bf16x8*)p, a1 = *(const bf16x8*)(p + 8), b0 = *(const bf16x8*)(p + 16), b1 = *(const bf16x8*)(p + 24);
    if (m >= MX) { *(bf16x8*)q = a0; *(bf16x8*)(q + 8) = a1; *(bf16x8*)(q + 16) = b0; *(bf16x8*)(q + 24) = b1; return; }
    const int t = m % T_, pos = half ? t % GW : t / GW; const float* tb = c.ROPE() + pos * 32;
    float oa[16], ob[16];
#pragma unroll
    for (int k = 0; k < 16; ++k) { const float va = k < 8 ? bfe(a0, k) : bfe(a1, k - 8), vb = k < 8 ? bfe(b0, k) : bfe(b1, k - 8), cs = tb[2 * k], sn = tb[2 * k + 1]; oa[k] = va * cs - vb * sn; ob[k] = vb * cs + va * sn; }
    u32x4 w; w.x = pk2(oa[0], oa[1]); w.y = pk2(oa[2], oa[3]); w.z = pk2(oa[4], oa[5]); w.w = pk2(oa[6], oa[7]); *(u32x4*)q = w;
    w.x = pk2(oa[8], oa[9]); w.y = pk2(oa[10], oa[11]); w.z = pk2(oa[12], oa[13]); w.w = pk2(oa[14], oa[15]); *(u32x4*)(q + 8) = w;
    w.x = pk2(ob[0], ob[1]); w.y = pk2(ob[2], ob[3]); w.z = pk2(ob[4], ob[5]); w.w = pk2(ob[6], ob[7]); *(u32x4*)(q + 16) = w;
    w.x = pk2(ob[8], ob[9]); w.y = pk2(ob[10], ob[11]); w.z = pk2(ob[12], ob[13]); w.w = pk2(ob[14], ob[15]); *(u32x4*)(q + 24) = w;
}
DEV void hgrn_scan4(const Ctx& c, long i) {
    const int e4 = (int)(i & 31), d = (int)((i >> 5) & 127), hh = (int)((i >> 12) & 3), b = (int)((i >> 14) % B_), dir = (int)((i >> 14) / B_);
    f32x4 S = {0.f, 0.f, 0.f, 0.f};
    int chunk = stream_chunk(dir, b, 0); float* p = c.HST() + (((size_t)dir * NCH + chunk) * 4 + hh) * 16384 + d * 128 + e4 * 4; f32x4 t = *(const f32x4*)p; float dec = c.BL()[((size_t)dir * NCH + chunk) * 512 + hh * 128 + d];
    for (int s = 0; s < NSC; ++s) { float* pn = p; f32x4 tn = t; float decn = dec;
        if (s + 1 < NSC) { const int cn = stream_chunk(dir, b, s + 1); pn = c.HST() + (((size_t)dir * NCH + cn) * 4 + hh) * 16384 + d * 128 + e4 * 4; tn = *(const f32x4*)pn; decn = c.BL()[((size_t)dir * NCH + cn) * 512 + hh * 128 + d]; }
        { u32x2 pk; pk.x = pk2(S[0], S[1]); pk.y = pk2(S[2], S[3]); *(u32x2*)(c.HSB() + (p - c.HST())) = pk; } S = S * fexp_(dec) + t; p = pn; t = tn; dec = decn; }
}
DEV void mlstm_scan4(const Ctx& c, long i) {
    const int e4 = (int)(i & 31), d = (int)((i >> 5) & 127), hh = (int)((i >> 12) & 3), b = (int)((i >> 14) % B_), dir = (int)((i >> 14) / B_);
    f32x4 C = {0.f, 0.f, 0.f, 0.f}; float n = 0.f, mm = 0.f;
    int chunk = stream_chunk(dir, b, 0); size_t oc = ((size_t)dir * NCH + chunk) * 4 + hh; float* p = c.MCs() + oc * 16384 + d * 128 + e4 * 4; f32x4 t = *(const f32x4*)p;
    for (int s = 0; s < NSC; ++s) { float* pn = p; f32x4 tn = t; size_t ocn = oc;
        if (s + 1 < NSC) { const int cn = stream_chunk(dir, b, s + 1); ocn = ((size_t)dir * NCH + cn) * 4 + hh; pn = c.MCs() + ocn * 16384 + d * 128 + e4 * 4; tn = *(const f32x4*)pn; }
        const float bl = c.MBL()[oc], ml = c.MML()[oc], mn = fmaxf(bl + mm, ml), ws = fexp_(bl + mm - mn), wl = fexp_(ml - mn);
        { u32x2 pk; pk.x = pk2(C[0], C[1]); pk.y = pk2(C[2], C[3]); *(u32x2*)(c.MSB() + (p - c.MCs())) = pk; } C = C * ws + t * wl;
        if (e4 == 0) { float* q = c.MN() + oc * 128 + d; const float tq = *q; *q = n; n = ws * n + wl * tq; if (d == 0) c.MMIN()[oc] = mm; }
        mm = mn; p = pn; t = tn; oc = ocn; }
}
}
constexpr int LDS_BYTES = 147456, MISC_OFF = 131072;
constexpr int CW_BAR = 1024;

struct EpiP {
    static constexpr bool PERM = true, AFTER_DRAIN = false;
    bf16_t* P; float* G;
    __device__ __forceinline__ void operator()(const pg8::f32x4 (&acc)[2][2][4][2], const pg8::Unit& u, int wr, int wc, int fr, int fq) const {
        const int row0 = u.pm * 256 + wr * 64 + fr;
        if (u.pn < NP / 256) {
            const int col0 = u.pn * 256 + wc * 32 + 8 * fq;
#pragma unroll
            for (int ai = 0; ai < 2; ++ai)
#pragma unroll
                for (int m = 0; m < 4; ++m) { bf16_t* rowp = P + (size_t)(row0 + ai * 128 + m * 16) * NP + col0;
#pragma unroll
                    for (int bj = 0; bj < 2; ++bj) { const pg8::f32x4 v0 = acc[ai][bj][m][0], v1 = acc[ai][bj][m][1];
                        pg8::u32x4 w; w.x = pg8::cvt_pk_bf16(v0[0], v0[1]); w.y = pg8::cvt_pk_bf16(v0[2], v0[3]); w.z = pg8::cvt_pk_bf16(v1[0], v1[1]); w.w = pg8::cvt_pk_bf16(v1[2], v1[3]);
                        *(pg8::u32x4*)(rowp + bj * 128) = w; } }
        } else if (wc == 0 && fq < 2) {
#pragma unroll
            for (int ai = 0; ai < 2; ++ai)
#pragma unroll
                for (int m = 0; m < 4; ++m) { float* rowp = G + (size_t)(row0 + ai * 128 + m * 16) * 16 + 8 * fq;
                    *(pg8::f32x4*)(rowp) = acc[ai][0][m][0]; *(pg8::f32x4*)(rowp + 4) = acc[ai][0][m][1]; }
        }
    }
};
struct EpiU {
    static constexpr bool PERM = true, AFTER_DRAIN = false;
    bf16_t* O;
    __device__ __forceinline__ void operator()(const pg8::f32x4 (&acc)[2][2][4][2], const pg8::Unit& u, int wr, int wc, int fr, int fq) const {
        const int row0 = u.pm * 256 + wr * 64 + fr, col0 = u.pn * 256 + wc * 32 + 8 * fq;
#pragma unroll
        for (int ai = 0; ai < 2; ++ai)
#pragma unroll
            for (int m = 0; m < 4; ++m) { bf16_t* rowp = O + (size_t)(row0 + ai * 128 + m * 16) * FF2 + col0;
#pragma unroll
                for (int bj = 0; bj < 2; ++bj) { const pg8::f32x4 v0 = acc[ai][bj][m][0], v1 = acc[ai][bj][m][1];
                    pg8::u32x4 w; w.x = pg8::cvt_pk_bf16(v0[0], v0[1]); w.y = pg8::cvt_pk_bf16(v0[2], v0[3]); w.z = pg8::cvt_pk_bf16(v1[0], v1[1]); w.w = pg8::cvt_pk_bf16(v1[2], v1[3]);
                    *(pg8::u32x4*)(rowp + bj * 128) = w; } }
    }
};
struct EpiRes {
    static constexpr bool PERM = true, AFTER_DRAIN = false;
    bf16_t* X; const float* gate; const float* Xsrc;
    __device__ __forceinline__ void operator()(const pg8::f32x4 (&acc)[2][2][4][2], const pg8::Unit& u, int wr, int wc, int fr, int fq) const {
        const int row0 = u.pm * 256 + wr * 64 + fr, col0 = u.pn * 256 + wc * 32 + 8 * fq;
#pragma unroll
        for (int ai = 0; ai < 2; ++ai)
#pragma unroll
            for (int m = 0; m < 4; ++m) { const int row = row0 + ai * 128 + m * 16; bf16_t* rowp = X + (size_t)row * D_ + col0; const float* gp = gate + (size_t)row_vec(row) * D6 + col0;
#pragma unroll
                for (int bj = 0; bj < 2; ++bj) { const pg8::f32x4 g0 = *(const pg8::f32x4*)(gp + bj * 128), g1 = *(const pg8::f32x4*)(gp + bj * 128 + 4); pg8::f32x4 x0, x1;
                    if (Xsrc) { const float* sp = Xsrc + (size_t)row * D_ + col0 + bj * 128; x0 = *(const pg8::f32x4*)sp; x1 = *(const pg8::f32x4*)(sp + 4); }
                    else { const pg8::u32x4 r = *(const pg8::u32x4*)(rowp + bj * 128);
                        x0 = (pg8::f32x4){__builtin_bit_cast(float, r.x << 16), __builtin_bit_cast(float, r.x & 0xffff0000u), __builtin_bit_cast(float, r.y << 16), __builtin_bit_cast(float, r.y & 0xffff0000u)};
                        x1 = (pg8::f32x4){__builtin_bit_cast(float, r.z << 16), __builtin_bit_cast(float, r.z & 0xffff0000u), __builtin_bit_cast(float, r.w << 16), __builtin_bit_cast(float, r.w & 0xffff0000u)}; }
                    const pg8::f32x4 v0 = x0 + g0 * acc[ai][bj][m][0], v1 = x1 + g1 * acc[ai][bj][m][1];
                    pg8::u32x4 w; w.x = pg8::cvt_pk_bf16(v0[0], v0[1]); w.y = pg8::cvt_pk_bf16(v0[2], v0[3]); w.z = pg8::cvt_pk_bf16(v1[0], v1[1]); w.w = pg8::cvt_pk_bf16(v1[2], v1[3]);
                    *(pg8::u32x4*)(rowp + bj * 128) = w; } }
    }
};
struct EpiPart {
    static constexpr bool PERM = true, AFTER_DRAIN = false;
    bf16_t* P; int kslice;
    __device__ __forceinline__ void operator()(const pg8::f32x4 (&acc)[2][2][4][2], const pg8::Unit& u, int wr, int wc, int fr, int fq) const {
        const int row0 = u.pm * 256 + wr * 64 + fr, col0 = u.pn * 256 + wc * 32 + 8 * fq; bf16_t* base = P + (size_t)(u.koff / kslice) * MCX * D_;
#pragma unroll
        for (int ai = 0; ai < 2; ++ai)
#pragma unroll
            for (int m = 0; m < 4; ++m) { bf16_t* rowp = base + (size_t)(row0 + ai * 128 + m * 16) * D_ + col0;
#pragma unroll
                for (int bj = 0; bj < 2; ++bj) { const pg8::f32x4 v0 = acc[ai][bj][m][0], v1 = acc[ai][bj][m][1];
                    pg8::u32x4 w; w.x = pg8::cvt_pk_bf16(v0[0], v0[1]); w.y = pg8::cvt_pk_bf16(v0[2], v0[3]); w.z = pg8::cvt_pk_bf16(v1[0], v1[1]); w.w = pg8::cvt_pk_bf16(v1[2], v1[3]);
                    *(pg8::u32x4*)(rowp + bj * 128) = w; } }
    }
};

struct CvtTile { const float* src; bf16_t* dst; int ldsrc, nsrc, K, k0, n0; };
__device__ __forceinline__ CvtTile cvt_tile_of(const Ctx& c, int t) {
    constexpr int T_IN = (D_ / 64) * (NPAD / 128), T_OUT = (DMIX / 64) * (D_ / 128), T_UP = (D_ / 64) * (FF2 / 128), T_DN = (FF_ / 64) * (D_ / 128), T_L = T_IN + T_OUT + T_UP + T_DN;
    const int l = t / T_L; int r = t % T_L; CvtTile q;
    if (r < T_IN) { q.src = c.w_in() + (size_t)l * D_ * DIN; q.dst = c.Wt_in() + (size_t)l * NPAD * D_; q.ldsrc = DIN; q.nsrc = DIN; q.K = D_; q.k0 = (r / (NPAD / 128)) * 64; q.n0 = (r % (NPAD / 128)) * 128; return q; }
    r -= T_IN;
    if (r < T_OUT) { q.src = c.w_out() + (size_t)l * DMIX * D_; q.dst = c.Wt_out() + (size_t)l * D_ * DMIX; q.ldsrc = D_; q.nsrc = D_; q.K = DMIX; q.k0 = (r / (D_ / 128)) * 64; q.n0 = (r % (D_ / 128)) * 128; return q; }
    r -= T_OUT;
    if (r < T_UP) { q.src = c.w_up() + (size_t)l * D_ * FF2; q.dst = c.Wt_up() + (size_t)l * FF2 * D_; q.ldsrc = FF2; q.nsrc = FF2; q.K = D_; q.k0 = (r / (FF2 / 128)) * 64; q.n0 = (r % (FF2 / 128)) * 128; return q; }
    r -= T_UP;
    q.src = c.w_down() + (size_t)l * FF_ * D_; q.dst = c.Wt_down() + (size_t)l * D_ * FF_; q.ldsrc = D_; q.nsrc = D_; q.K = FF_; q.k0 = (r / (D_ / 128)) * 64; q.n0 = (r % (D_ / 128)) * 128; return q;
}
constexpr int CVT_T_IN = (D_ / 64) * (NPAD / 128), CVT_T_OUT = (DMIX / 64) * (D_ / 128), CVT_T_UP = (D_ / 64) * (FF2 / 128), CVT_T_DN = (FF_ / 64) * (D_ / 128);
constexpr int CVT_T_L = CVT_T_IN + CVT_T_OUT + CVT_T_UP + CVT_T_DN, CVT_T_ALL = L_ * CVT_T_L;
constexpr int CVT_B = 4;
static_assert(CVT_T_IN % CVT_B == 0 && CVT_T_OUT % CVT_B == 0 && CVT_T_UP % CVT_B == 0 && CVT_T_DN % CVT_B == 0, "conversion batches must not straddle matrices");
__device__ __forceinline__ void convert_batch(const Ctx& c, LAS float* tile, const int tid, const int t0) {
    typedef float f32x4 __attribute__((ext_vector_type(4)));
    f32x4 v[4];
#define CVT_LOAD(q) do { _Pragma("unroll") for (int i_ = 0; i_ < 4; ++i_) { const int idx_ = tid + 512 * i_, kr_ = idx_ >> 5, n_ = (q).n0 + (idx_ & 31) * 4; \
        v[i_] = n_ < (q).nsrc ? *(const f32x4*)((q).src + (size_t)((q).k0 + kr_) * (q).ldsrc + n_) : (f32x4){0.f, 0.f, 0.f, 0.f}; } } while (0)
    { const CvtTile q = cvt_tile_of(c, t0); CVT_LOAD(q); }
    for (int b = 0; b < CVT_B; ++b) {
        const CvtTile q = cvt_tile_of(c, t0 + b);
#pragma unroll
        for (int i = 0; i < 4; ++i) { const int idx = tid + 512 * i, kr = idx >> 5, n4 = (idx & 31) * 4;
#pragma unroll
            for (int j = 0; j < 4; ++j) tile[kr * 129 + n4 + j] = v[i][j]; }
        __syncthreads();
        if (b + 1 < CVT_B) { const CvtTile qn = cvt_tile_of(c, t0 + b + 1); CVT_LOAD(qn); }
#pragma unroll
        for (int i = 0; i < 2; ++i) { const int idx = tid + 512 * i, n = idx >> 3, kc = idx & 7; float x[8];
#pragma unroll
            for (int j = 0; j < 8; ++j) x[j] = tile[(kc * 8 + j) * 129 + n];
            fa::u32x4 pk; pk.x = fa::pk2(x[0], x[1]); pk.y = fa::pk2(x[2], x[3]); pk.z = fa::pk2(x[4], x[5]); pk.w = fa::pk2(x[6], x[7]);
            *(fa::u32x4*)(q.dst + (size_t)(q.n0 + n) * q.K + q.k0 + kc * 8) = pk; }
        __syncthreads();
    }
#undef CVT_LOAD
}
__device__ __forceinline__ void convert_pull(const Ctx& c, LAS float* tile, volatile LAS unsigned* misc, const int need, const int quota) {
    unsigned* ctr = c.ctl() + 8192 + 64 * 40;
    for (int n = 0;; ++n) {
        int tid_ = threadIdx.x; asm volatile("" : "+v"(tid_));
        if (tid_ == 0) { unsigned idx = 0xffffffffu; const unsigned cur = __hip_atomic_load(ctr, __ATOMIC_RELAXED, __HIP_MEMORY_SCOPE_AGENT);
            if (cur < (unsigned)CVT_T_ALL && (n < quota || cur < (unsigned)need)) idx = __hip_atomic_fetch_add(ctr, (unsigned)CVT_B, __ATOMIC_RELAXED, __HIP_MEMORY_SCOPE_AGENT);
            misc[5] = idx; }
        __syncthreads();
        const unsigned t = (unsigned)__builtin_amdgcn_readfirstlane((int)misc[5]);
        __syncthreads();
        if (t >= (unsigned)CVT_T_ALL) break;
        convert_batch(c, tile, tid_, (int)t);
    }
}

struct Args { const float* in[20]; float* out; unsigned char* ws; int ph_lo, ph_hi; };

#define IN_(k) (lo <= (k) && (k) < hi)
#define BAR_IF if (ph + 1 < hi) xcd_barrier(bar);
#define PROGRAM_HEAD
#define PH_BEGIN if (IN_(ph)) {
#define SEG(N, CALL) { Ctx c = c0; asm volatile("" : "+s"(c.ws)); unsigned t0_ = threadIdx.x; asm volatile("" : "+v"(t0_)); for (long i = (long)blockIdx.x * 512 + t0_; i < (long)(N); i += gsz) { CALL; } }
#define PH_END BAR_IF } ++ph;
#define DIFF_ATTN(l, co) { const int nu_ = fa::N_DIFF_LAT + ((co) ? fa::N_DIFF_CTX : 0); for (int u_ = blockIdx.x; u_ < nu_; u_ += gridDim.x) fa::diff_unit(c, l, ldsp, u_); }
#define DIFF_POST(l)
#define WAVES(N, CALL) { Ctx c = c0; asm volatile("" : "+s"(c.ws)); int tid_ = threadIdx.x; asm volatile("" : "+v"(tid_)); const int lane_ = tid_ & 63; \
    for (long wi_ = (long)blockIdx.x * 8 + __builtin_amdgcn_readfirstlane(tid_ >> 6); wi_ < (long)(N); wi_ += (long)gridDim.x * 8) { CALL; } }
#define QUEUE(QIDX, N, CALL) { unsigned* qc_ = c.ctl() + 8192 + 64 * (QIDX); \
    for (;;) { int tid_ = threadIdx.x; asm volatile("" : "+v"(tid_)); if (tid_ == 0) misc[4] = __hip_atomic_fetch_add(qc_, 1u, __ATOMIC_RELAXED, __HIP_MEMORY_SCOPE_AGENT); __syncthreads(); \
        const int u_ = __builtin_amdgcn_readfirstlane((int)misc[4]); __syncthreads(); if (u_ >= (N)) break; CALL; } }
#define M2_PHASE(l, co) { const int nH_ = ch::N_HG_STREAMS, nS_ = nH_ + ch::N_ML_STREAMS, nD_ = fa::N_DIFF_LAT + ((co) ? fa::N_DIFF_CTX : 0), nN_ = fa::N_NA_LAT + ((co) ? fa::N_NA_CTX : 0); \
    QUEUE(2 * (l), nS_ + nD_ + nN_ + ch::N_CH2_UNITS, { if (u_ < nH_) ch::hgrn_stream_unit(c, ldsp, tid_, u_); else if (u_ < nS_) ch::mlstm_stream_unit(c, l, ldsp, tid_, u_ - nH_); else if (u_ < nS_ + nD_) fa::diff_unit(c, l, ldsp, u_ - nS_); \
        else if (u_ < nS_ + nD_ + nN_) fa::na_unit(c, l, ldsp, u_ - nS_ - nD_); else ch::hgrn_out2_unit(c, l, ldsp, tid_, u_ - nS_ - nD_ - nN_); }) \
    if ((l) + 1 < L_) { constexpr int NCK_ = KPARTS * (D6 / 4) / 512; QUEUE(24 + (l), NCK_, { thin::modp4<0>(c, ((l) + 1) * (long)(KPARTS * (D6 / 4)) + (long)u_ * 512 + tid_); }) } }
#define UNITS(N, CALL) { int tid_ = threadIdx.x; asm volatile("" : "+v"(tid_)); for (int u_ = blockIdx.x; u_ < (N); u_ += gridDim.x) { CALL; } }
#define ML_LOCAL UNITS(ch::N_CH_UNITS, ch::local_state_unit<1>(c, ldsp, tid_, u_))
#define HG_LOCAL UNITS(ch::N_CH_UNITS, ch::local_state_unit<0>(c, ldsp, tid_, u_))
#define ML_QK
#define HG_SCORE
#define ML_OUT
#define NA_S1(l)
#define NA_S2(l, co) { const int nu_ = fa::N_NA_LAT + ((co) ? fa::N_NA_CTX : 0); for (int u_ = blockIdx.x; u_ < nu_; u_ += gridDim.x) fa::na_unit(c, l, ldsp, u_); }
#define NA_S3(l)
#define CONVERT_WEIGHTS convert_pull(c, (LAS float*)ldsp, misc, CVT_T_IN, 0);
#define CVT_NEED(need) convert_pull(c, (LAS float*)ldsp, misc, need, 0);
#define CVT_SPARE(rem, quota) if ((int)blockIdx.x >= (rem)) convert_pull(c, (LAS float*)ldsp, misc, 0, quota);
#define GEMM_IN(l) if (IN_(ph)) { pg8::Gemm g{c.Hb(), c.Wt_in() + (size_t)(l) * NPAD * D_, MT, NPAD, D_, D_}; pg8::StaticOrder S; S.init(MT, NPAD, (int)gridDim.x, (int)blockIdx.x); \
    EpiP E{c.Pb(), c.G()}; pg8::gemm_phase<EpiP, pg8::StaticOrder>(ldsp, g, S, E, nullptr); CVT_SPARE(S.nwg % (int)gridDim.x, 3) BAR_IF } ++ph;
#define GEMM_RES(Aptr, Wptr, mr, KK_, goff, S_, XS_) if (IN_(ph)) { const int G_ = (int)gridDim.x; \
    { pg8::Gemm g{Aptr, Wptr, MX, D_, KK_, KK_}; pg8::StaticOrder S; S.init(MX, D_, G_, (int)blockIdx.x); \
      EpiRes E{c.XB(), c.MOD() + (size_t)(l) * NV * D6 + (goff), XS_}; pg8::gemm_phase<EpiRes, pg8::StaticOrder>(ldsp, g, S, E, nullptr); } \
    if ((mr) > MX) { pg8::Gemm g{(Aptr) + (size_t)MX * (KK_), Wptr, MCX, D_, (KK_) / (S_), KK_}; pg8::TailOrder S; S.init(MCX, D_, G_, (int)blockIdx.x, S_, (KK_) / (S_)); \
      EpiPart E{(bf16_t*)c.PARTS(), (KK_) / (S_)}; pg8::gemm_phase<EpiPart, pg8::TailOrder>(ldsp, g, S, E, nullptr); CVT_SPARE(32 * (S_), 3) } \
    BAR_IF } ++ph;
#define GEMM_OUT(l, mr) GEMM_RES(c.Y(), c.Wt_out() + (size_t)(l) * D_ * DMIX, mr, DMIX, 2 * D_, 8, ((l) == 0 ? c.x_in() : (const float*)nullptr))
#define GEMM_UP(l, mr) if (IN_(ph)) { pg8::Gemm g{c.Hb(), c.Wt_up() + (size_t)(l) * FF2 * D_, mr, FF2, D_, D_}; pg8::StaticOrder S; S.init(mr, FF2, (int)gridDim.x, (int)blockIdx.x); \
    EpiU E{c.U()}; pg8::gemm_phase<EpiU, pg8::StaticOrder>(ldsp, g, S, E, nullptr); CVT_SPARE(S.nwg % (int)gridDim.x, 4) BAR_IF } ++ph;
#define GEMM_DOWN(l, mr) GEMM_RES(c.ACT(), c.Wt_down() + (size_t)(l) * D_ * FF_, mr, FF_, 5 * D_, 4, (const float*)nullptr)

__global__ void __launch_bounds__(512, 2) mega(Args a) {
    extern __shared__ __attribute__((aligned(16))) unsigned char lds[];
    PG8_LAS unsigned char* ldsp = (PG8_LAS unsigned char*)lds;
    Ctx c0; c0.ws = a.ws;
    const Ctx& c = c0;
    volatile LAS unsigned* misc = (volatile LAS unsigned*)(ldsp + MISC_OFF);
    if (threadIdx.x < 4) misc[threadIdx.x] = 0u;
    __syncthreads();
    const int lo = a.ph_lo, hi = a.ph_hi;
    XcdBarrier bar; bar.bar = c.ctl() + CW_BAR; bar.x = 0; bar.st = misc;
    if (hi - lo > 1) bar = xcd_barrier_post(c.ctl() + CW_BAR, misc);
    const long gsz = (long)gridDim.x * 512;
    int ph = 0;
constexpr int NPH_GPU = 2 + L_ * 10 + 1;
{
    PH_BEGIN SEG(N_P0, st_prologue(c, i)) SEG((long)KPARTS * (D6 / 4), thin::modp4<1>(c, i)) CONVERT_WEIGHTS PH_END
    PH_BEGIN SEG((long)NV * D6, st_modr(c, i)) PH_END
    for (int l = 0; l < L_; ++l) {
        const int ctx_out = l < L_ - 1; const int mrows = ctx_out ? MT : MX;
        PH_BEGIN WAVES(MX / 4, thin::mod_row<4>(c, l, 0, 4 * (int)wi_, lane_, 0, c.MOD())) WAVES(2 * MCX, if ((wi_ & 7) < 4) thin::mod_row<1>(c, l, 0, MX + (int)((wi_ >> 3) * 4 + (wi_ & 7)), lane_, l > 0 ? 4 : 0, c.MOD() + ((size_t)(l > 0 ? l - 1 : 0) * NV + B_) * D6 + 5 * D_)) CVT_NEED(l * CVT_T_L + CVT_T_IN) PH_END
        GEMM_IN(l)
        PH_BEGIN SEG(2L * NCH * 512, thin::hgrn_decay_scan(c, l, i)) WAVES(2L * NCH * 4, thin::mlstm_gates(c, l, wi_, lane_)) SEG((long)MT * 32, thin::rope16(c, i)) PH_END
        PH_BEGIN M2_PHASE(l, ctx_out) PH_END
        PH_BEGIN SEG((long)MT * 64, thin::post8(c, l, i)) CVT_NEED(l * CVT_T_L + CVT_T_IN + CVT_T_OUT) PH_END
        GEMM_OUT(l, mrows)
        PH_BEGIN WAVES(MX / 4, thin::mod_row<4>(c, l, 1, 4 * (int)wi_, lane_, 0, c.MOD())) WAVES(2 * MCX, if ((wi_ & 7) < 4) thin::mod_row<1>(c, l, 1, MX + (int)((wi_ >> 3) * 4 + (wi_ & 7)), lane_, ctx_out ? 8 : 0, c.MOD() + ((size_t)l * NV + B_) * D6 + 2 * D_)) CVT_NEED(l * CVT_T_L + CVT_T_IN + CVT_T_OUT + CVT_T_UP) PH_END
        GEMM_UP(l, mrows)
        PH_BEGIN SEG((long)thin::CONV_STRIPS * thin::CONV_J8, thin::conv_strip(c, l, i, mrows)) if (l + 1 < L_) SEG((long)NV * D6, st_modr(c, (long)(l + 1) * NV * D6 + i)) CVT_NEED((l + 1) * CVT_T_L) PH_END
        GEMM_DOWN(l, mrows)
    }
    PH_BEGIN WAVES(MX / 4, thin::final_row(c, (int)wi_, lane_)) PH_END
}
}

extern "C" void kernel_launch(void* const* d_in, const int* in_sizes, int n_in, void* d_out, int out_size, void* d_ws, size_t ws_size, hipStream_t stream) {
    static int grid = 0;
    if (grid == 0) {
        const size_t need = WS_TOTAL;
        if (n_in != 20 || out_size != MX * D_ || ws_size < need) { fprintf(stderr, "kernel_launch: unexpected shapes (n_in %d, out %d, ws %zu, need %zu)\n", n_in, out_size, ws_size, need); grid = -1; return; }
        int dev = 0, cus = 0, per_cu = 0;
        if (hipGetDevice(&dev) != hipSuccess || hipDeviceGetAttribute(&cus, hipDeviceAttributeMultiprocessorCount, dev) != hipSuccess) { grid = -1; return; }
        if (hipFuncSetAttribute((const void*)mega, hipFuncAttributeMaxDynamicSharedMemorySize, LDS_BYTES) != hipSuccess) { fprintf(stderr, "kernel_launch: hipFuncSetAttribute failed\n"); grid = -1; return; }
        if (hipOccupancyMaxActiveBlocksPerMultiprocessor(&per_cu, (const void*)mega, 512, LDS_BYTES) != hipSuccess || per_cu < 1) fprintf(stderr, "kernel_launch: occupancy query says %d\n", per_cu);
        (void)hipGetLastError();
        grid = cus;
    }
    if (grid < 0) return;
    (void)hipMemsetAsync(d_ws, 0, (size_t)(1 << 16) * sizeof(unsigned), stream);
    Args a{};
    for (int i = 0; i < 20; ++i) a.in[i] = (const float*)d_in[i];
    a.out = (float*)d_out; a.ws = (unsigned char*)d_ws;
#if ONE_LAUNCH
    a.ph_lo = 0; a.ph_hi = 2 + L_ * 10 + 1;
    hipLaunchKernelGGL(mega, dim3(grid), dim3(512), LDS_BYTES, stream, a);
#else
    for (int p = 0; p < 2 + L_ * 10 + 1; ++p) { a.ph_lo = p; a.ph_hi = p + 1; hipLaunchKernelGGL(mega, dim3(grid), dim3(512), LDS_BYTES, stream, a); }
#endif
}
```
